# Optimizing an MI355X kernel written in HIP

```python
import jax
import jax.numpy as jnp
from jax import lax
import numpy as np


D_MODEL = 1024
BATCH = 4
SEQ = 8192
DEPTH = 2

GRID_W = 64
CTX_LEN = 256
HEAD_DIM = 64
ATT_Q_HEADS = 8
ATT_KV_HEADS = 2
ATT_GROUP = ATT_Q_HEADS // ATT_KV_HEADS
WINDOW = 128
ATT_BLOCK = 128
ROPE_BASE = 10000.0
ROPE_AXIS_DIM = HEAD_DIM // 2
RWKV_HEADS = 4
RWKV_WIDTH = RWKV_HEADS * HEAD_DIM
W_LORA = 32
A_LORA = 32
V_LORA = 32
G_LORA = 64
RWKV_GN_EPS = 64e-5
MLSTM_HEADS = 4
MLSTM_HEAD_DIM = 64
MLSTM_WIDTH = MLSTM_HEADS * MLSTM_HEAD_DIM
MLSTM_CHUNK = 64
MLSTM_GN_EPS = 1e-5
N_DIRS = 2
ATT_Q_W = ATT_Q_HEADS * HEAD_DIM
ATT_KV_W = ATT_KV_HEADS * HEAD_DIM
ATT_IN = ATT_Q_W + 2 * ATT_KV_W
RWKV_IN = 3 * RWKV_WIDTH + N_DIRS * (W_LORA + A_LORA) + G_LORA
RWKV_SPLITS = [RWKV_WIDTH, 2 * RWKV_WIDTH, 3 * RWKV_WIDTH, 3 * RWKV_WIDTH + N_DIRS * W_LORA, 3 * RWKV_WIDTH + N_DIRS * (W_LORA + A_LORA)]
MLSTM_GATES = N_DIRS * 2 * MLSTM_HEADS
MLSTM_IN = 4 * MLSTM_WIDTH + MLSTM_GATES
IN_WIDTH = ATT_IN + RWKV_IN + MLSTM_IN
MIX_WIDTH = ATT_Q_W + RWKV_WIDTH + MLSTM_WIDTH
N_EXPERTS = 32
TOP_K = 4
D_FF = D_MODEL
SWIGLU_LIMIT = 7.0
SWIGLU_ALPHA = 1.702
MOE_BLOCK = 256
N_MOD = 6
NORM_EPS = 1e-6
CONV_W = 3

kernel_name = "hybrid_rwkv7_mlstm_swa_moe_dit"


def rms_norm(x, g):
    xf = x.astype(jnp.float32)
    y = xf * lax.rsqrt(jnp.mean(xf * xf, axis=-1, keepdims=True) + NORM_EPS)
    return (y * g.astype(jnp.float32)).astype(x.dtype)


def modulate(h, shift, scale):
    return h * (1 + scale) + shift


def head_norm(y, w, b, eps):
    mu = jnp.mean(y, axis=-1, keepdims=True)
    yc = y - mu
    yn = yc * lax.rsqrt(jnp.mean(yc * yc, axis=-1, keepdims=True) + eps) * w.reshape(y.shape[-2:])
    return yn if b is None else yn + b.reshape(y.shape[-2:])


def heads(t, n_heads):
    return t.reshape(*t.shape[:-1], n_heads, t.shape[-1] // n_heads)


def conv3(x, w):
    xp = jnp.pad(x, ((0, 0), (1, 1), (0, 0)))
    return xp[:, :-2] * w[0] + xp[:, 1:-1] * w[1] + xp[:, 2:] * w[2]


def axial_rope_tables(T):
    rows = T // GRID_W
    row = jnp.repeat(jnp.arange(rows, dtype=jnp.float32), GRID_W)
    col = jnp.tile(jnp.arange(GRID_W, dtype=jnp.float32), rows)
    inv_freq = ROPE_BASE ** (-jnp.arange(0, ROPE_AXIS_DIM, 2, dtype=jnp.float32) / ROPE_AXIS_DIM)
    ang = jnp.concatenate([row[:, None] * inv_freq, col[:, None] * inv_freq], axis=-1)
    return jnp.cos(ang), jnp.sin(ang)


def apply_axial_rope(x, cos, sin):
    T = x.shape[1]
    half = ROPE_AXIS_DIM // 2
    xr = x.astype(jnp.float32).reshape(*x.shape[:-1], 2, 2, half)
    c = cos.reshape(T, 2, half)[None, :, None]
    s = sin.reshape(T, 2, half)[None, :, None]
    x1, x2 = xr[..., 0, :], xr[..., 1, :]
    out = jnp.stack([x1 * c - x2 * s, x2 * c + x1 * s], axis=-2)
    return out.reshape(x.shape).astype(x.dtype)


def sink_column(sink, lead_shape):
    return jnp.broadcast_to(sink.reshape(ATT_KV_HEADS, ATT_GROUP, 1, 1).astype(jnp.float32), lead_shape + (1,))


def window_attention(q, k, v, kc, vc, sink):
    B, T, _, d = q.shape
    Lc = kc.shape[1]
    nb = T // ATT_BLOCK
    span = ATT_BLOCK + 2 * WINDOW
    scale = d ** -0.5
    qb = jnp.moveaxis(q.reshape(B, nb, ATT_BLOCK, ATT_KV_HEADS, ATT_GROUP, d), 1, 0)
    kp = jnp.pad(k, ((0, 0), (WINDOW, WINDOW), (0, 0), (0, 0)))
    vp = jnp.pad(v, ((0, 0), (WINDOW, WINDOW), (0, 0), (0, 0)))

    def one_block(args):
        qblk, j = args
        start = j * ATT_BLOCK
        kb = lax.dynamic_slice_in_dim(kp, start, span, axis=1)
        vb = lax.dynamic_slice_in_dim(vp, start, span, axis=1)
        qpos = start + jnp.arange(ATT_BLOCK)
        kpos = start - WINDOW + jnp.arange(span)
        ok = (jnp.abs(qpos[:, None] - kpos[None, :]) <= WINDOW) & (kpos[None, :] >= 0) & (kpos[None, :] < T)
        s_loc = jnp.where(ok, jnp.einsum('bqkgd,bskd->bkgqs', qblk, kb).astype(jnp.float32) * scale, -jnp.inf)
        s_ctx = jnp.einsum('bqkgd,bskd->bkgqs', qblk, kc).astype(jnp.float32) * scale
        p = jax.nn.softmax(jnp.concatenate([s_loc, s_ctx, sink_column(sink, s_loc.shape[:-1])], axis=-1), axis=-1).astype(v.dtype)
        return (jnp.einsum('bkgqs,bskd->bqkgd', p[..., :span], vb)
                + jnp.einsum('bkgqs,bskd->bqkgd', p[..., span:span + Lc], vc))

    ob = lax.map(one_block, (qb, jnp.arange(nb)))
    return jnp.moveaxis(ob, 0, 1).reshape(B, T, ATT_Q_HEADS * d)


def context_attention(qc, kc, vc, sink):
    B, L, _, d = qc.shape
    qg = qc.reshape(B, L, ATT_KV_HEADS, ATT_GROUP, d)
    s = jnp.einsum('bqkgd,bskd->bkgqs', qg, kc).astype(jnp.float32) * d ** -0.5
    p = jax.nn.softmax(jnp.concatenate([s, sink_column(sink, s.shape[:-1])], axis=-1), axis=-1)[..., :L].astype(vc.dtype)
    return jnp.einsum('bkgqs,bskd->bqkgd', p, vc).reshape(B, L, ATT_Q_HEADS * d)


def attention_group(u, uc, sink, cos, sin, need_ctx):
    q, k, v = jnp.split(u, [ATT_Q_W, ATT_Q_W + ATT_KV_W], axis=-1)
    qc, kc, vc = jnp.split(uc, [ATT_Q_W, ATT_Q_W + ATT_KV_W], axis=-1)
    q = apply_axial_rope(heads(q, ATT_Q_HEADS), cos, sin)
    k = apply_axial_rope(heads(k, ATT_KV_HEADS), cos, sin)
    kc, vc = heads(kc, ATT_KV_HEADS), heads(vc, ATT_KV_HEADS)
    o = window_attention(q, k, heads(v, ATT_KV_HEADS), kc, vc, sink)
    oc = context_attention(heads(qc, ATT_Q_HEADS), kc, vc, sink) if need_ctx else None
    return o, oc


def bidirectional(scan_fn, lat_seqs, ctx_seqs, init, need_ctx):
    ys, ycs = [], []
    for d in range(N_DIRS):
        rev = d == 1
        flip = (lambda t: jnp.flip(t, axis=1)) if rev else (lambda t: t)
        yc, state = scan_fn(tuple(flip(t) for t in ctx_seqs[d]), init, need_ctx)
        y, _ = scan_fn(tuple(flip(t) for t in lat_seqs[d]), state, True)
        ys.append(flip(y))
        ycs.append(flip(yc) if need_ctx else None)
    return ys, ycs


def rwkv7_scan(seqs, state, emit):
    def step(S, inp):
        w_t, k_t, v_t, kk_t, a_t = inp[:5]
        sa = jnp.einsum('bhvk,bhk->bhv', S, -kk_t)
        S = (S * w_t[:, :, None, :] + sa[..., None] * (kk_t * a_t)[:, :, None, :]
             + v_t[..., None] * k_t[:, :, None, :])
        y = jnp.einsum('bhvk,bhk->bhv', S, inp[5]) if emit else None
        return S, y
    S, ys = lax.scan(step, state, tuple(jnp.moveaxis(t, 1, 0) for t in seqs))
    return (jnp.moveaxis(ys, 0, 1) if emit else None), S


def value_residual(h, v, v_first, v0, v_down, v_up):
    return v + (v_first - v) * jax.nn.sigmoid(v0 + (h @ v_down) @ v_up)


def rwkv_mixer(f, fc, w0, w_up, a0, a_up, g_up, k_k, k_a, r_k, ln_w, ln_b, need_ctx):
    f32 = jnp.float32

    def scan_inputs(feats, d, emit):
        r, k, v, xw, xa, _ = feats
        logit = (w0[d] + jnp.tanh(xw[..., d * W_LORA:(d + 1) * W_LORA]) @ w_up[d]).astype(f32)
        decay = jnp.exp(-jnp.exp(-jax.nn.softplus(-logit) - 0.5))
        a = jax.nn.sigmoid((a0[d] + xa[..., d * A_LORA:(d + 1) * A_LORA] @ a_up[d]).astype(f32))
        kk = heads((k * k_k).astype(f32), RWKV_HEADS)
        kk = kk / jnp.maximum(jnp.sqrt(jnp.sum(kk * kk, axis=-1, keepdims=True)), 1e-12)
        k_d = k.astype(f32) * (1.0 + (a - 1.0) * k_a)
        seqs = (heads(decay, RWKV_HEADS), heads(k_d, RWKV_HEADS), heads(v.astype(f32), RWKV_HEADS), kk, heads(a, RWKV_HEADS))
        return seqs + ((heads(r.astype(f32), RWKV_HEADS),) if emit else ())

    def readout(y, seqs):
        k_d, v, r = seqs[1], seqs[2], seqs[5]
        bonus = jnp.sum(r * k_d * r_k, axis=-1, keepdims=True) * v
        return head_norm(y, ln_w, ln_b, RWKV_GN_EPS) + bonus

    def merge(ys, seqs_list, xg):
        o = sum(readout(y, s) for y, s in zip(ys, seqs_list))
        o = o.reshape(*o.shape[:2], RWKV_WIDTH)
        return (o * (jax.nn.sigmoid(xg.astype(f32)) @ g_up)).astype(xg.dtype)

    lat = [scan_inputs(f, d, True) for d in range(N_DIRS)]
    ctx = [scan_inputs(fc, d, need_ctx) for d in range(N_DIRS)]
    init = jnp.zeros((f[0].shape[0], RWKV_HEADS, HEAD_DIM, HEAD_DIM), f32)
    ys, ycs = bidirectional(rwkv7_scan, lat, ctx, init, need_ctx)
    return merge(ys, lat, f[5]), (merge(ycs, ctx, fc[5]) if need_ctx else None)


def mlstm_chunk_scan(seqs, state, emit):
    k = seqs[0]
    B, T, H, _ = k.shape
    L = MLSTM_CHUNK
    nc = T // L

    def chunks(t):
        t = t.reshape(B, nc, L, H, *t.shape[3:])
        return jnp.moveaxis(jnp.moveaxis(t, 1, 0), 3, 2)

    tril = jnp.tril(jnp.ones((L, L), dtype=bool))

    def step(carry, inp):
        C, n, m = carry
        kc, vc, ic, fc = inp[:4]
        b = jnp.cumsum(fc, axis=-1)
        g = b[..., -1]
        lw = g[..., None] - b + ic
        m_new = jnp.maximum(g + m, jnp.max(lw, axis=-1))
        wk = jnp.exp(lw - m_new[..., None])
        keep = jnp.exp(g + m - m_new)
        C_new = keep[..., None, None] * C + jnp.einsum('bhs,bhsk,bhsv->bhkv', wk, kc, vc)
        n_new = keep[..., None] * n + jnp.einsum('bhs,bhsk->bhk', wk, kc)
        out = None
        if emit:
            qc = inp[4]
            dlog = jnp.where(tril, b[..., :, None] - b[..., None, :] + ic[..., None, :], -jnp.inf)
            m_inter = b + m[..., None]
            m_t = jnp.maximum(jnp.max(dlog, axis=-1), m_inter)
            w_inter = jnp.exp(m_inter - m_t)
            s = jnp.einsum('bhtk,bhsk->bhts', qc, kc) * jnp.exp(dlog - m_t[..., None])
            num = w_inter[..., None] * jnp.einsum('bhtk,bhkv->bhtv', qc, C) + jnp.einsum('bhts,bhsv->bhtv', s, vc)
            den = w_inter * jnp.einsum('bhtk,bhk->bht', qc, n) + jnp.sum(s, axis=-1)
            out = num / jnp.maximum(jnp.abs(den), jnp.exp(-m_t))[..., None]
        return (C_new, n_new, m_new), out

    state, hs = lax.scan(step, state, tuple(chunks(t) for t in seqs))
    if not emit:
        return None, state
    return jnp.moveaxis(jnp.moveaxis(hs, 2, 3), 0, 1).reshape(B, T, H, -1), state


def mlstm_features(u, conv_w):
    qk, v, o, g = jnp.split(u, [2 * MLSTM_WIDTH, 3 * MLSTM_WIDTH, 4 * MLSTM_WIDTH], axis=-1)
    q, k = jnp.split(jax.nn.silu(conv3(qk, conv_w)), 2, axis=-1)
    return (q, k, v, o, g)


def mlstm_mixer(f, fc, gate_b, ln_w, need_ctx):
    f32 = jnp.float32

    def scan_inputs(feats, d, emit):
        q, k, v, _, g = feats
        g = (g + gate_b).astype(f32).reshape(*g.shape[:-1], N_DIRS, 2, MLSTM_HEADS)
        seqs = (heads(k.astype(f32), MLSTM_HEADS) * MLSTM_HEAD_DIM ** -0.5, heads(v.astype(f32), MLSTM_HEADS),
                g[..., d, 0, :], jax.nn.log_sigmoid(g[..., d, 1, :]))
        return seqs + ((heads(q.astype(f32), MLSTM_HEADS),) if emit else ())

    def merge(ys, feats):
        hn = head_norm(sum(ys), ln_w, None, MLSTM_GN_EPS)
        hn = hn.reshape(*hn.shape[:2], MLSTM_WIDTH)
        return (jax.nn.sigmoid(feats[3].astype(f32)) * hn).astype(feats[3].dtype)

    B = f[0].shape[0]
    init = (jnp.zeros((B, MLSTM_HEADS, MLSTM_HEAD_DIM, MLSTM_HEAD_DIM), f32),
            jnp.zeros((B, MLSTM_HEADS, MLSTM_HEAD_DIM), f32), jnp.zeros((B, MLSTM_HEADS), f32))
    lat = [scan_inputs(f, d, True) for d in range(N_DIRS)]
    ctx = [scan_inputs(fc, d, need_ctx) for d in range(N_DIRS)]
    ys, ycs = bidirectional(mlstm_chunk_scan, lat, ctx, init, need_ctx)
    return merge(ys, f), (merge(ycs, fc) if need_ctx else None)


def expert_ffn(xb, w1, b1, w2, b2):
    glu, lin = jnp.split(xb @ w1 + b1, 2, axis=-1)
    glu = jnp.minimum(glu, SWIGLU_LIMIT)
    lin = jnp.clip(lin, -SWIGLU_LIMIT, SWIGLU_LIMIT)
    return (glu * jax.nn.sigmoid(SWIGLU_ALPHA * glu) * (lin + 1)) @ w2 + b2


def moe_ffn(h, router_w, router_b, w1, b1, w2, b2):
    T, D = h.shape
    logits = (h @ router_w + router_b).astype(jnp.float32)
    top_v, top_i = lax.top_k(logits, TOP_K)
    gates = jax.nn.softmax(top_v, axis=-1)
    n = T * TOP_K
    eid = top_i.reshape(n)
    tok = jnp.arange(n, dtype=jnp.int32) // TOP_K
    order = jnp.argsort(eid)
    eid_s, tok_s, g_s = eid[order], tok[order], gates.reshape(n)[order]
    counts = jnp.bincount(eid, length=N_EXPERTS)
    padded = (counts + MOE_BLOCK - 1) // MOE_BLOCK * MOE_BLOCK
    pend = jnp.cumsum(padded)
    pstart = pend - padded
    ustart = jnp.cumsum(counts) - counts
    dest = pstart[eid_s] + jnp.arange(n, dtype=jnp.int32) - ustart[eid_s]
    n_pad = (n + N_EXPERTS * (MOE_BLOCK - 1) + MOE_BLOCK - 1) // MOE_BLOCK * MOE_BLOCK
    nblk = n_pad // MOE_BLOCK
    ptok = jnp.full((n_pad,), T, jnp.int32).at[dest].set(tok_s)
    pgate = jnp.zeros((n_pad,), h.dtype).at[dest].set(g_s.astype(h.dtype))
    blk_e = jnp.minimum(jnp.searchsorted(pend, jnp.arange(nblk) * MOE_BLOCK, side='right'), N_EXPERTS - 1)
    hpad = jnp.concatenate([h, jnp.zeros((1, D), h.dtype)], axis=0)
    xb = hpad[ptok].reshape(nblk, MOE_BLOCK, D)

    def one_block(args):
        xblk, e = args
        return expert_ffn(xblk, w1[e], b1[e], w2[e], b2[e])

    yb = lax.map(one_block, (xb, blk_e)).reshape(n_pad, D) * pgate[:, None]
    return jnp.zeros((T + 1, D), h.dtype).at[ptok].add(yb)[:T]


def setup_inputs(seed: int = 0) -> dict:
    key = jax.random.key(seed)
    ks = iter(jax.random.split(key, 40))

    def nrm(shape, scale):
        return scale * jax.random.normal(next(ks), shape, jnp.float32)

    L = DEPTH
    conv_base = jnp.array([0.25, 0.5, 0.25], jnp.float32)[None, :, None]
    fg_base = jnp.linspace(3.0, 6.0, MLSTM_HEADS, dtype=jnp.float32)
    return {
        'x': nrm((BATCH, SEQ, D_MODEL), 1.0),
        'c': nrm((BATCH, D_MODEL), 1.0),
        'ctx': nrm((BATCH, CTX_LEN, D_MODEL), 1.0),
        'c_ctx': nrm((D_MODEL,), 1.0),
        'norm1_g': 1.0 + nrm((L, D_MODEL), 0.1),
        'norm2_g': 1.0 + nrm((L, D_MODEL), 0.1),
        'ada_w': nrm((L, D_MODEL, N_MOD * D_MODEL), 0.5 * D_MODEL ** -0.5),
        'ada_b': nrm((L, N_MOD * D_MODEL), 0.02),
        'w_in': nrm((L, D_MODEL, IN_WIDTH), D_MODEL ** -0.5),
        'w_out': nrm((L, MIX_WIDTH, D_MODEL), MIX_WIDTH ** -0.5),
        'attn_sink': nrm((L, ATT_Q_HEADS), 0.5),
        'rwkv_conv': conv_base + nrm((L, CONV_W, RWKV_IN), 0.1),
        'rwkv_w0': jnp.linspace(-6.0, -1.0, RWKV_WIDTH, dtype=jnp.float32) + nrm((L, N_DIRS, RWKV_WIDTH), 0.1),
        'rwkv_w_up': nrm((L, N_DIRS, W_LORA, RWKV_WIDTH), 0.1),
        'rwkv_a0': nrm((L, N_DIRS, RWKV_WIDTH), 0.1),
        'rwkv_a_up': nrm((L, N_DIRS, A_LORA, RWKV_WIDTH), 0.5 * A_LORA ** -0.5),
        'rwkv_g_up': nrm((L, G_LORA, RWKV_WIDTH), G_LORA ** -0.5),
        'rwkv_k_k': 0.85 + nrm((L, RWKV_WIDTH), 0.05),
        'rwkv_k_a': 1.0 + nrm((L, RWKV_WIDTH), 0.05),
        'rwkv_r_k': nrm((L, RWKV_HEADS, HEAD_DIM), 0.1),
        'rwkv_ln_w': 1.0 + nrm((L, RWKV_WIDTH), 0.1),
        'rwkv_ln_b': nrm((L, RWKV_WIDTH), 0.02),
        'rwkv_v0': 1.0 + nrm((L - 1, RWKV_WIDTH), 0.1),
        'rwkv_v_down': nrm((L - 1, D_MODEL, V_LORA), D_MODEL ** -0.5),
        'rwkv_v_up': nrm((L - 1, V_LORA, RWKV_WIDTH), 0.5 * V_LORA ** -0.5),
        'mlstm_conv': conv_base + nrm((L, CONV_W, 2 * MLSTM_WIDTH), 0.1),
        'mlstm_gate_b': jnp.concatenate([nrm((L, N_DIRS, 1, MLSTM_HEADS), 0.1),
                                         fg_base + nrm((L, N_DIRS, 1, MLSTM_HEADS), 0.1)], axis=2).reshape(L, MLSTM_GATES),
        'mlstm_ln_w': 1.0 + nrm((L, MLSTM_WIDTH), 0.1),
        'router_w': nrm((L, D_MODEL, N_EXPERTS), D_MODEL ** -0.5),
        'router_b': nrm((L, N_EXPERTS), 0.01),
        'moe_w1': nrm((L, N_EXPERTS, D_MODEL, 2 * D_FF), D_MODEL ** -0.5),
        'moe_b1': nrm((L, N_EXPERTS, 2 * D_FF), 0.02),
        'moe_w2': nrm((L, N_EXPERTS, D_FF, D_MODEL), D_FF ** -0.5),
        'moe_b2': nrm((L, N_EXPERTS, D_MODEL), 0.02),
        'final_norm_g': 1.0 + nrm((D_MODEL,), 0.1),
    }


def reference(x, c, ctx, c_ctx, norm1_g, norm2_g, ada_w, ada_b, w_in, w_out, attn_sink,
              rwkv_conv, rwkv_w0, rwkv_w_up, rwkv_a0, rwkv_a_up, rwkv_g_up, rwkv_k_k, rwkv_k_a,
              rwkv_r_k, rwkv_ln_w, rwkv_ln_b, rwkv_v0, rwkv_v_down, rwkv_v_up,
              mlstm_conv, mlstm_gate_b, mlstm_ln_w,
              router_w, router_b, moe_w1, moe_b1, moe_w2, moe_b2, final_norm_g):
    B, T, D = x.shape
    cos, sin = axial_rope_tables(T)
    xc = ctx
    v_first = v_first_c = None
    for l in range(DEPTH):
        need_ctx = l < DEPTH - 1
        mod = (jax.nn.silu(c) @ ada_w[l] + ada_b[l]).reshape(B, N_MOD, 1, D)
        mod_c = (jax.nn.silu(c_ctx) @ ada_w[l] + ada_b[l]).reshape(N_MOD, D)
        h = modulate(rms_norm(x, norm1_g[l]), mod[:, 0], mod[:, 1])
        hc = modulate(rms_norm(xc, norm1_g[l]), mod_c[0], mod_c[1])
        u_att, u_rw, u_ml = jnp.split(h @ w_in[l], [ATT_IN, ATT_IN + RWKV_IN], axis=-1)
        c_att, c_rw, c_ml = jnp.split(hc @ w_in[l], [ATT_IN, ATT_IN + RWKV_IN], axis=-1)
        o_att, oc_att = attention_group(u_att, c_att, attn_sink[l], cos, sin, need_ctx)
        f_rw = list(jnp.split(conv3(u_rw, rwkv_conv[l]), RWKV_SPLITS, axis=-1))
        fc_rw = list(jnp.split(conv3(c_rw, rwkv_conv[l]), RWKV_SPLITS, axis=-1))
        if l == 0:
            v_first, v_first_c = f_rw[2], fc_rw[2]
        else:
            f_rw[2] = value_residual(h, f_rw[2], v_first, rwkv_v0[l - 1], rwkv_v_down[l - 1], rwkv_v_up[l - 1])
            fc_rw[2] = value_residual(hc, fc_rw[2], v_first_c, rwkv_v0[l - 1], rwkv_v_down[l - 1], rwkv_v_up[l - 1])
        o_rw, oc_rw = rwkv_mixer(f_rw, fc_rw, rwkv_w0[l], rwkv_w_up[l], rwkv_a0[l], rwkv_a_up[l], rwkv_g_up[l],
                                 rwkv_k_k[l], rwkv_k_a[l], rwkv_r_k[l], rwkv_ln_w[l], rwkv_ln_b[l], need_ctx)
        o_ml, oc_ml = mlstm_mixer(mlstm_features(u_ml, mlstm_conv[l]), mlstm_features(c_ml, mlstm_conv[l]),
                                  mlstm_gate_b[l], mlstm_ln_w[l], need_ctx)
        x = x + mod[:, 2] * (jnp.concatenate([o_att, o_rw, o_ml], axis=-1) @ w_out[l])
        h2 = modulate(rms_norm(x, norm2_g[l]), mod[:, 3], mod[:, 4])
        if need_ctx:
            xc = xc + mod_c[2] * (jnp.concatenate([oc_att, oc_rw, oc_ml], axis=-1) @ w_out[l])
            h2c = modulate(rms_norm(xc, norm2_g[l]), mod_c[3], mod_c[4])
            y = moe_ffn(jnp.concatenate([h2.reshape(B * T, D), h2c.reshape(-1, D)], axis=0),
                        router_w[l], router_b[l], moe_w1[l], moe_b1[l], moe_w2[l], moe_b2[l])
            x = x + mod[:, 5] * y[:B * T].reshape(B, T, D)
            xc = xc + mod_c[5] * y[B * T:].reshape(xc.shape)
        else:
            y = moe_ffn(h2.reshape(B * T, D), router_w[l], router_b[l], moe_w1[l], moe_b1[l], moe_w2[l], moe_b2[l])
            x = x + mod[:, 5] * y.reshape(B, T, D)
    return rms_norm(x, final_norm_g)
```

```cpp
#include <hip/hip_runtime.h>
#include <hip/hip_cooperative_groups.h>
#include <cstdio>
#include <cstdint>
namespace cg = cooperative_groups;

#define LAS __attribute__((address_space(3)))
typedef unsigned short bf16_t;
typedef unsigned u32x4 __attribute__((ext_vector_type(4)));
typedef unsigned u32x2 __attribute__((ext_vector_type(2)));
typedef float f32x4 __attribute__((ext_vector_type(4)));
typedef float f32x2 __attribute__((ext_vector_type(2)));
typedef short bf16x8 __attribute__((ext_vector_type(8)));

constexpr int D = 1024, NB = 4, T = 8192, LC = 256;
constexpr int NLAT = NB * T, NCTX = NB * LC, NTOK = NLAT + NCTX;
constexpr int INW = 2768, INP = 2816;
constexpr int UC_Q = 0, UC_K = 512, UC_V = 640, UC_RW = 768, UC_ML = 1728, UC_HV = 2784;
constexpr int NE = 32, CAP = NTOK;
constexpr int NWAVES = 8, NTHR = 512;
constexpr int LDS_BYTES = 147456;
constexpr int MISC_OFF = 131072;

constexpr size_t MiB = 1u << 20;
constexpr size_t WS_CTL = 0, CTL_ZERO_BYTES = 65536;
constexpr size_t WS_MOD = 1 * MiB;
constexpr size_t WS_ROPE = 1 * MiB + 512 * 1024;
constexpr size_t WS_GATE = 2 * MiB;
constexpr size_t WS_LIST = 3 * MiB;
constexpr size_t WS_WIN = 8 * MiB;
constexpr size_t WS_WOUT = 20 * MiB;
constexpr size_t WS_W1 = 24 * MiB;
constexpr size_t WS_W2 = 280 * MiB;
constexpr size_t WS_X = 408 * MiB;
constexpr size_t WS_H = 540 * MiB;
constexpr size_t WS_MIX = 606 * MiB;
constexpr size_t WS_VF = 672 * MiB;
constexpr size_t WS_SCR = 706 * MiB;
constexpr size_t WS_U = WS_SCR;
constexpr size_t WS_QR = WS_SCR + 182 * MiB;
constexpr size_t WS_KR = WS_SCR + 215 * MiB;
constexpr size_t WS_RWA = WS_SCR + 224 * MiB;
constexpr size_t RWA_STRIDE = 33 * MiB;
enum { RA_R = 0, RA_V, RA_KK, RA_G, RA_LW0, RA_LW1, RA_A0, RA_A1, RA_KD0, RA_KD1, RA_Y0, RA_Y1 };
constexpr size_t WS_MQ = WS_SCR + 620 * MiB;
constexpr size_t WS_MK = WS_SCR + 653 * MiB;
constexpr size_t WS_GT = WS_SCR + 686 * MiB;
constexpr size_t WS_MO0 = WS_SCR + 689 * MiB;
constexpr size_t WS_MO1 = WS_SCR + 722 * MiB;
constexpr size_t WS_HB = WS_SCR;
constexpr size_t WS_YK = WS_SCR + 264 * MiB;
constexpr size_t WS_END = WS_SCR + 755 * MiB;
constexpr int CW_CNT = 0;
constexpr int CW_ATT = 128;

struct KP {
    const float* in[35];
    float* out;
    unsigned char* ws;
    int ph_lo, ph_hi;
};
enum { I_X = 0, I_C, I_CTX, I_CCTX, I_N1G, I_N2G, I_ADAW, I_ADAB, I_WIN, I_WOUT, I_SINK, I_RCONV, I_RW0, I_RWUP, I_RA0, I_RAUP, I_RGUP, I_RKK, I_RKA, I_RRK,
       I_RLNW, I_RLNB, I_RV0, I_RVDOWN, I_RVUP, I_MCONV, I_MGB, I_MLNW, I_ROUTW, I_ROUTB, I_W1, I_B1, I_W2, I_B2, I_FNG };

__device__ __forceinline__ unsigned f2bf(float f) { unsigned u = __float_as_uint(f); return (u + 0x7fffu + ((u >> 16) & 1u)) >> 16; }
__device__ __forceinline__ unsigned pk2(float lo, float hi) { return f2bf(lo) | (f2bf(hi) << 16); }
__device__ __forceinline__ float bf2f(bf16_t b) { return __uint_as_float(((unsigned)b) << 16); }
__device__ __forceinline__ float bflo(unsigned w) { return __uint_as_float(w << 16); }
__device__ __forceinline__ float bfhi(unsigned w) { return __uint_as_float(w & 0xffff0000u); }
__device__ __forceinline__ float sigm(float x) { return 1.f / (1.f + __expf(-x)); }
__device__ __forceinline__ float wsum(float v) {
#pragma unroll
    for (int o = 32; o; o >>= 1) v += __shfl_xor(v, o);
    return v;
}
__device__ __forceinline__ float wmax(float v) {
#pragma unroll
    for (int o = 32; o; o >>= 1) v = fmaxf(v, __shfl_xor(v, o));
    return v;
}
__device__ __forceinline__ float gsum16(float v) {
#pragma unroll
    for (int o = 8; o; o >>= 1) v += __shfl_xor(v, o);
    return v;
}
__device__ __forceinline__ float rlane(float x, int k) { return __int_as_float(__builtin_amdgcn_readlane(__float_as_int(x), k)); }
#define LDS_FENCE() asm volatile("s_waitcnt lgkmcnt(0)" ::: "memory")

namespace pg8 {
constexpr int BM = 256, BK = 64, HALF = 128, HTB = HALF * BK * 2, KD = 1024, NT = KD / BK;
__host__ __device__ __forceinline__ int lds_byte(int r, int c) { const int st = (r >> 4) * 2 + (c >> 5), rr = r & 15, cc = c & 31, ob = rr * 64 + cc * 2; return st * 1024 + (ob ^ (((ob >> 9) & 1) << 5)); }
__host__ __device__ __forceinline__ void stage_rc(int b, int& R, int& C) { const int st = b / 1024, sb = b % 1024, swz = sb ^ (((sb >> 9) & 1) << 5); R = (st >> 1) * 16 + swz / 64; C = (st & 1) * 32 + (swz % 64) / 2; }
__host__ __device__ __forceinline__ int perm32(int rho) { const int n = rho >> 4, i = rho & 15; return 8 * (i >> 2) + 4 * n + (i & 3); }
struct Unit { int pm, pn, e, rows; };

struct DenseOrder {
    int nM, nN, nwg, G, c; const unsigned char* Bt;
    __device__ void init(int M, int N, int G_, int c_, const void* Bt_) { nM = M / BM; nN = N / BM; nwg = nM * nN; G = G_; c = c_; Bt = (const unsigned char*)Bt_; }
    __device__ __forceinline__ bool next(int i, Unit& u) const {
        const long L = (long)i * G + c; if (L >= nwg) return false;
        int wgid = (int)L; { const int q = nwg / 8, r = nwg % 8, xcd = wgid % 8, off = wgid / 8; wgid = (xcd < r ? xcd * (q + 1) : r * (q + 1) + (xcd - r) * q) + off; }
        const int nig = 8 * nN, gid = wgid / nig, fm = gid * 8, gsz = (nM - fm) < 8 ? (nM - fm) : 8;
        u.pm = fm + ((wgid % nig) % gsz); u.pn = (wgid % nig) / gsz; u.e = 0; u.rows = 256; return true;
    }
    __device__ __forceinline__ unsigned arow_off(const Unit& u, int r) const { return (unsigned)(u.pm * BM + r) * (unsigned)(KD * 2); }
    __device__ __forceinline__ const unsigned char* bbase(const Unit& u) const { return Bt + (size_t)u.pn * BM * KD * 2; }
};
struct MoeOrder {
    const LAS int* tp; const int* list; const int* cnt; int npn, G, c, shift; const unsigned char* Bt; size_t bstride;
    __device__ __forceinline__ bool next(int i, Unit& u) const {
        const long L = (long)i * G + c; const int total = tp[32] * npn; if (L >= total) return false;
        const int tl = (int)(L / npn); u.pn = (int)(L % npn);
        int e = 0;
#pragma unroll
        for (int j = 0; j < 32; ++j) e += (tp[j + 1] <= tl) ? 1 : 0;
        e = __builtin_amdgcn_readfirstlane(e); u.e = e; u.pm = __builtin_amdgcn_readfirstlane(tl - tp[e]); u.pn = __builtin_amdgcn_readfirstlane(u.pn);
        const int rem = cnt[e] - u.pm * BM; u.rows = __builtin_amdgcn_readfirstlane(rem < BM ? rem : BM); return true;
    }
    __device__ __forceinline__ unsigned arow_off(const Unit& u, int r) const {
        const int idx = u.pm * BM + (r < u.rows ? r : 0);
        const int entry = list[(size_t)u.e * CAP + idx]; return (unsigned)(entry >> shift) * (unsigned)(KD * 2);
    }
    __device__ __forceinline__ const unsigned char* bbase(const Unit& u) const { return Bt + (size_t)u.e * bstride + (size_t)u.pn * BM * KD * 2; }
};

template <class Epi, class Sched>
__device__ __forceinline__ void gemm_phase(LAS unsigned char* lds, const unsigned char* Abase, const Sched& S, const Epi& E) {
    const int tid = threadIdx.x, wid = __builtin_amdgcn_readfirstlane(tid >> 6), lane = tid & 63, wr = wid >> 2, wc = wid & 3, fr = lane & 15, fq = lane >> 4;
    constexpr int nt = NT;
    int sR[2], sC[2]; unsigned voffB[2];
#pragma unroll
    for (int i = 0; i < 2; ++i) { int R, C; stage_rc(tid * 16 + i * 8192, R, C); sR[i] = R; sC[i] = C; const int Rb = Epi::PERM ? ((R & ~31) + perm32(R & 31)) : R; voffB[i] = (unsigned)(Rb * KD + C) * 2u; }
    const size_t kstep = (size_t)(BK * 2);
    const size_t hstep = (size_t)HALF * KD * 2;
    const unsigned ldsw = (unsigned)wid * 1024u;
    const int aoff = lds_byte(wr * 64 + fr, fq * 8), boff = lds_byte(wc * 32 + fr, fq * 8);
#define PG8_SA(b, h) (((b) * 2 + (h)) * HTB)
#define PG8_SB(b, h) ((4 + (b) * 2 + (h)) * HTB)
#define PG8_STAGE(bufoff, gbase, voff) do { _Pragma("unroll") for (int _i = 0; _i < 2; ++_i) \
        __builtin_amdgcn_global_load_lds((const unsigned*)((const unsigned char*)(gbase) + (voff)[_i]), (LAS unsigned*)(lds + (bufoff) + ldsw + _i * 8192), 16, 0, 0); } while (0)
#define PG8_LDA(dst, b, h) do { _Pragma("unroll") for (int m = 0; m < 4; ++m) _Pragma("unroll") for (int k = 0; k < 2; ++k) dst[m][k] = *(const LAS bf16x8*)(lds + PG8_SA(b, h) + aoff + m * 2048 + k * 1024); } while (0)
#define PG8_LDB(dst, b, h) do { _Pragma("unroll") for (int n = 0; n < 2; ++n) _Pragma("unroll") for (int k = 0; k < 2; ++k) dst[n][k] = *(const LAS bf16x8*)(lds + PG8_SB(b, h) + boff + n * 2048 + k * 1024); } while (0)
#define PG8_MMA(ai, bj, At, Bt) do { __builtin_amdgcn_s_setprio(1); _Pragma("unroll") for (int m = 0; m < 4; ++m) _Pragma("unroll") for (int n = 0; n < 2; ++n) _Pragma("unroll") for (int k = 0; k < 2; ++k) \
        acc[ai][bj][m][n] = __builtin_amdgcn_mfma_f32_16x16x32_bf16(Bt[n][k], At[m][k], acc[ai][bj][m][n], 0, 0, 0); __builtin_amdgcn_s_setprio(0); } while (0)
#define PG8_WAIT_V(n) asm volatile("s_waitcnt vmcnt(" #n ")" ::: "memory")
#define PG8_WAIT_L(n) asm volatile("s_waitcnt lgkmcnt(" #n ")" ::: "memory")
#define PG8_BAR __builtin_amdgcn_s_barrier()
#define PG8_SCHED __builtin_amdgcn_sched_barrier(0)
    Unit cur, nxt; int ui = 0;
    if (!S.next(0, cur)) return;
    f32x4 acc[2][2][4][2];
#pragma unroll
    for (int a = 0; a < 2; ++a)
#pragma unroll
        for (int b = 0; b < 2; ++b)
#pragma unroll
            for (int m = 0; m < 4; ++m)
#pragma unroll
                for (int n = 0; n < 2; ++n) acc[a][b][m][n] = (f32x4){0.f, 0.f, 0.f, 0.f};
    bf16x8 At[4][2], B0[2][2], B1[2][2];
    unsigned vA[2][2], nvA[2][2];
#pragma unroll
    for (int h = 0; h < 2; ++h)
#pragma unroll
        for (int i = 0; i < 2; ++i) vA[h][i] = S.arow_off(cur, h * HALF + sR[i]) + (unsigned)sC[i] * 2u;
    const unsigned char* cB = S.bbase(cur);
    PG8_STAGE(PG8_SB(0, 0), cB, voffB); PG8_STAGE(PG8_SB(0, 1), cB + hstep, voffB); PG8_STAGE(PG8_SA(0, 0), Abase, vA[0]); PG8_STAGE(PG8_SA(0, 1), Abase, vA[1]);
    if (wr == 1) PG8_BAR;
    PG8_WAIT_V(2); PG8_BAR;
    PG8_STAGE(PG8_SB(1, 0), cB + kstep, voffB); PG8_STAGE(PG8_SA(1, 0), Abase + kstep, vA[0]); PG8_STAGE(PG8_SB(1, 1), cB + hstep + kstep, voffB);
    PG8_WAIT_V(6); PG8_BAR;
    for (;;) {
        const bool has_next = S.next(ui + 1, nxt);
        const unsigned char* nB = has_next ? S.bbase(nxt) : cB;
#pragma unroll
        for (int h = 0; h < 2; ++h)
#pragma unroll
            for (int i = 0; i < 2; ++i) nvA[h][i] = has_next ? (S.arow_off(nxt, h * HALF + sR[i]) + (unsigned)sC[i] * 2u) : vA[h][i];
        for (int t = 0; t < nt; t += 2) {
            const bool last = (t == nt - 2);
            const unsigned char* a1 = Abase + (size_t)(t + 1) * kstep;
            const unsigned char* a2 = last ? Abase : Abase + (size_t)(t + 2) * kstep;
            const unsigned char* b2 = last ? nB : cB + (size_t)(t + 2) * kstep;
            const unsigned char* a3 = a2 + kstep; const unsigned char* b3 = b2 + kstep;
            unsigned wA0[2], wA1[2];
#pragma unroll
            for (int i = 0; i < 2; ++i) { wA0[i] = last ? nvA[0][i] : vA[0][i]; wA1[i] = last ? nvA[1][i] : vA[1][i]; }
            PG8_LDB(B0, 0, 0); PG8_LDB(B1, 0, 1); PG8_SCHED; PG8_LDA(At, 0, 0); PG8_STAGE(PG8_SA(1, 1), a1, vA[1]);
            PG8_WAIT_V(8); PG8_WAIT_L(0); PG8_BAR; PG8_MMA(0, 0, At, B0); PG8_MMA(0, 1, At, B1); PG8_BAR; PG8_SCHED;
            PG8_LDA(At, 0, 1); PG8_STAGE(PG8_SB(0, 0), b2, voffB); PG8_STAGE(PG8_SB(0, 1), b2 + hstep, voffB); PG8_STAGE(PG8_SA(0, 0), a2, wA0);
            PG8_WAIT_V(8); PG8_WAIT_L(0); PG8_BAR; PG8_MMA(1, 0, At, B0); PG8_MMA(1, 1, At, B1); PG8_BAR; PG8_SCHED;
            PG8_LDB(B0, 1, 0); PG8_LDB(B1, 1, 1); PG8_SCHED; PG8_LDA(At, 1, 0); PG8_STAGE(PG8_SA(0, 1), a2, wA1);
            PG8_WAIT_V(8); PG8_WAIT_L(0); PG8_BAR; PG8_MMA(0, 0, At, B0); PG8_MMA(0, 1, At, B1); PG8_BAR; PG8_SCHED;
            PG8_LDA(At, 1, 1); PG8_STAGE(PG8_SB(1, 0), b3, voffB); PG8_STAGE(PG8_SB(1, 1), b3 + hstep, voffB); PG8_STAGE(PG8_SA(1, 0), a3, wA0);
            PG8_WAIT_V(8); PG8_WAIT_L(0); PG8_BAR; PG8_MMA(1, 0, At, B0); PG8_MMA(1, 1, At, B1); PG8_BAR; PG8_SCHED;
        }
        if (wr == 0) PG8_BAR;
        E(acc, cur, wr, wc, fr, fq);
        if (!has_next) break;
#pragma unroll
        for (int a = 0; a < 2; ++a)
#pragma unroll
            for (int b = 0; b < 2; ++b)
#pragma unroll
                for (int m = 0; m < 4; ++m)
#pragma unroll
                    for (int n = 0; n < 2; ++n) acc[a][b][m][n] = (f32x4){0.f, 0.f, 0.f, 0.f};
        cur = nxt; cB = nB; ++ui;
#pragma unroll
        for (int h = 0; h < 2; ++h)
#pragma unroll
            for (int i = 0; i < 2; ++i) vA[h][i] = nvA[h][i];
        if (wr == 1) PG8_BAR;
    }
    PG8_WAIT_V(0);
    PG8_BAR;
#undef PG8_SA
#undef PG8_SB
#undef PG8_STAGE
#undef PG8_LDA
#undef PG8_LDB
#undef PG8_MMA
#undef PG8_WAIT_V
#undef PG8_WAIT_L
#undef PG8_BAR
#undef PG8_SCHED
}
}

namespace pg8 {
struct EpiInProj {
    static constexpr bool PERM = true;
    bf16_t* O;
    __device__ __forceinline__ void operator()(const f32x4 (&acc)[2][2][4][2], const Unit& u, int wr, int wc, int fr, int fq) const {
        const int row0 = u.pm * BM + wr * 64 + fr, col0 = u.pn * BM + wc * 32 + 8 * fq;
#pragma unroll
        for (int ai = 0; ai < 2; ++ai)
#pragma unroll
            for (int m = 0; m < 4; ++m) { bf16_t* rowp = O + (size_t)(row0 + ai * HALF + m * 16) * INP + col0;
#pragma unroll
                for (int bj = 0; bj < 2; ++bj) { const f32x4 v0 = acc[ai][bj][m][0], v1 = acc[ai][bj][m][1];
                    u32x4 w; w.x = pk2(v0[0], v0[1]); w.y = pk2(v0[2], v0[3]); w.z = pk2(v1[0], v1[1]); w.w = pk2(v1[2], v1[3]);
                    *(u32x4*)(rowp + bj * HALF) = w; } }
    }
};
struct EpiOutProj {
    static constexpr bool PERM = false;
    const float* xlat; const float* xctx; float* xbuf; const float* mod;
    __device__ __forceinline__ void operator()(const f32x4 (&acc)[2][2][4][2], const Unit& u, int wr, int wc, int fr, int fq) const {
        const int rowt = u.pm * BM; const int mrow = rowt < NLAT ? (rowt >> 13) : 4;
        const float* gate = mod + mrow * 6144 + 2 * 1024;
        const float* src = rowt < NLAT ? xlat + (size_t)rowt * D : xctx + (size_t)(rowt - NLAT) * D;
        float* dst = xbuf + (size_t)rowt * D;
#pragma unroll
        for (int ai = 0; ai < 2; ++ai)
#pragma unroll
            for (int m = 0; m < 4; ++m) { const int r = ai * HALF + wr * 64 + m * 16 + fr;
#pragma unroll
                for (int bj = 0; bj < 2; ++bj)
#pragma unroll
                    for (int n = 0; n < 2; ++n) { const int c = u.pn * BM + bj * HALF + wc * 32 + n * 16 + 4 * fq;
                        const f32x4 g = *(const f32x4*)(gate + c); const f32x4 xv = *(const f32x4*)(src + (size_t)r * D + c);
                        *(f32x4*)(dst + (size_t)r * D + c) = xv + g * acc[ai][bj][m][n]; } }
    }
};
__device__ __forceinline__ float swiglu(float g, float l) { g = fminf(g, 7.f); l = fminf(fmaxf(l, -7.f), 7.f); return g * sigm(1.702f * g) * (l + 1.f); }
struct EpiMoe1 {
    static constexpr bool PERM = true;
    const int* list; const float* b1; bf16_t* H;
    __device__ __forceinline__ void operator()(const f32x4 (&acc)[2][2][4][2], const Unit& u, int wr, int wc, int fr, int fq) const {
        const int hc = u.pn * 128 + wc * 32 + 8 * fq;
        const float* bg = b1 + (size_t)u.e * 2048 + hc; const float* bl = bg + 1024;
        const f32x4 bg0 = *(const f32x4*)bg, bg1 = *(const f32x4*)(bg + 4), bl0 = *(const f32x4*)bl, bl1 = *(const f32x4*)(bl + 4);
#pragma unroll
        for (int ai = 0; ai < 2; ++ai)
#pragma unroll
            for (int m = 0; m < 4; ++m) { const int r = ai * HALF + wr * 64 + m * 16 + fr;
                if (r < u.rows) { const int entry = list[(size_t)u.e * CAP + u.pm * BM + r];
                    const f32x4 g0 = acc[ai][0][m][0] + bg0, g1 = acc[ai][0][m][1] + bg1, l0 = acc[ai][1][m][0] + bl0, l1 = acc[ai][1][m][1] + bl1;
                    u32x4 w; w.x = pk2(swiglu(g0[0], l0[0]), swiglu(g0[1], l0[1])); w.y = pk2(swiglu(g0[2], l0[2]), swiglu(g0[3], l0[3]));
                    w.z = pk2(swiglu(g1[0], l1[0]), swiglu(g1[1], l1[1])); w.w = pk2(swiglu(g1[2], l1[2]), swiglu(g1[3], l1[3]));
                    *(u32x4*)(H + (size_t)entry * 1024 + hc) = w; } }
    }
};
struct EpiMoe2 {
    static constexpr bool PERM = true;
    const int* list; const float* b2; const float* gate; bf16_t* YK;
    __device__ __forceinline__ void operator()(const f32x4 (&acc)[2][2][4][2], const Unit& u, int wr, int wc, int fr, int fq) const {
        const int c0 = u.pn * BM + wc * 32 + 8 * fq;
        const float* bb = b2 + (size_t)u.e * 1024 + c0;
        f32x4 bv[2][2];
#pragma unroll
        for (int bj = 0; bj < 2; ++bj) { bv[bj][0] = *(const f32x4*)(bb + bj * HALF); bv[bj][1] = *(const f32x4*)(bb + bj * HALF + 4); }
#pragma unroll
        for (int ai = 0; ai < 2; ++ai)
#pragma unroll
            for (int m = 0; m < 4; ++m) { const int r = ai * HALF + wr * 64 + m * 16 + fr;
                if (r < u.rows) { const int entry = list[(size_t)u.e * CAP + u.pm * BM + r]; const float g = gate[entry];
#pragma unroll
                    for (int bj = 0; bj < 2; ++bj) { const f32x4 v0 = (acc[ai][bj][m][0] + bv[bj][0]) * g, v1 = (acc[ai][bj][m][1] + bv[bj][1]) * g;
                        u32x4 w; w.x = pk2(v0[0], v0[1]); w.y = pk2(v0[2], v0[3]); w.z = pk2(v1[0], v1[1]); w.w = pk2(v1[2], v1[3]);
                        *(u32x4*)(YK + (size_t)entry * 1024 + c0 + bj * HALF) = w; } } }
    }
};
}

#define WSP(T_, off) ((T_*)(p.ws + (off)))
#define RWA(i) WSP(float, WS_RWA + (size_t)(i) * RWA_STRIDE)

__device__ __forceinline__ void transpose_item(const float* W, int ldw, int n0, int nvalid, int k0, bf16_t* WT, int drow0, LAS float* scr, int lane) {
    const int n = n0 + (lane & 31); const bool ok = n < nvalid;
#pragma unroll 8
    for (int i = 0; i < 32; ++i) { const int kk = 2 * i + (lane >> 5); scr[kk * 33 + (lane & 31)] = ok ? W[(size_t)(k0 + kk) * ldw + n] : 0.f; }
    LDS_FENCE();
    const int c = lane & 7;
#pragma unroll
    for (int j = 0; j < 4; ++j) { const int nn = (lane >> 3) + 8 * j; const LAS float* s = scr + (8 * c) * 33 + nn;
        u32x4 o; o.x = pk2(s[0], s[33]); o.y = pk2(s[66], s[99]); o.z = pk2(s[132], s[165]); o.w = pk2(s[198], s[231]);
        *(u32x4*)(WT + (size_t)(drow0 + nn) * 1024 + k0 + 8 * c) = o; }
    LDS_FENCE();
}
__device__ __forceinline__ void phase_p0a(const KP& p, LAS unsigned char* lds) {
    const int tid = threadIdx.x, lane = tid & 63, wave = tid >> 6;
    const int gw = blockIdx.x * NWAVES + wave, ngw = gridDim.x * NWAVES;
    float* MOD = WSP(float, WS_MOD);
    for (int it = blockIdx.x; it < 192; it += gridDim.x) {
        const int l = it / 96, cb = it % 96, n = cb * 64 + lane;
        const float* W = p.in[I_ADAW] + (size_t)l * 1024 * 6144;
        float acc[5] = {0.f, 0.f, 0.f, 0.f, 0.f};
        for (int k = wave * 128; k < wave * 128 + 128; ++k) {
            const float w = W[(size_t)k * 6144 + n];
#pragma unroll
            for (int r = 0; r < 5; ++r) { const float cv = r < 4 ? p.in[I_C][r * 1024 + k] : p.in[I_CCTX][k]; acc[r] += (cv * sigm(cv)) * w; }
        }
        LAS float* red = (LAS float*)lds;
#pragma unroll
        for (int r = 0; r < 5; ++r) red[(wave * 5 + r) * 64 + lane] = acc[r];
        __syncthreads();
        if (wave < 5) { float s = 0.f;
#pragma unroll
            for (int w = 0; w < 8; ++w) s += red[(w * 5 + wave) * 64 + lane];
            MOD[(size_t)(l * 5 + wave) * 6144 + n] = s + p.in[I_ADAB][l * 6144 + n]; }
        __syncthreads();
    }
    { const int gt = blockIdx.x * NTHR + tid; if (gt < 2048) { const int pos = gt >> 4, f = gt & 15;
        const float inv = powf(10000.f, -(float)f / 16.f); const float ang = (float)pos * inv; float* RT = WSP(float, WS_ROPE); RT[gt * 2] = cosf(ang); RT[gt * 2 + 1] = sinf(ang); } }
    LAS float* scr = (LAS float*)(lds + 16384) + wave * (64 * 33);
    constexpr int IT_WIN = 2 * 16 * 88, IT_WOUT = 2 * 16 * 32, IT_W1 = 2 * 32 * 16 * 64, IT_W2 = 2 * 32 * 16 * 32;
    for (int it = gw; it < IT_WIN + IT_WOUT + IT_W1 + IT_W2; it += ngw) {
        int r = it;
        if (r < IT_WIN) { const int l = r / 1408, q = r % 1408, kb = q / 88, nb = q % 88; bf16_t* dst = WSP(bf16_t, WS_WIN) + (size_t)l * INP * 1024;
            if (nb < 87) transpose_item(p.in[I_WIN] + (size_t)l * 1024 * INW, INW, nb * 32, INW, kb * 64, dst, nb * 32, scr, lane);
            else if (l == 1) transpose_item(p.in[I_RVDOWN], 32, 0, 32, kb * 64, dst, UC_HV, scr, lane);
            else transpose_item(p.in[I_RVDOWN], 32, 0, 0, kb * 64, dst, UC_HV, scr, lane);
            continue; }
        r -= IT_WIN;
        if (r < IT_WOUT) { const int l = r / 512, q = r % 512, kb = q / 32, nb = q % 32;
            transpose_item(p.in[I_WOUT] + (size_t)l * 1024 * 1024, 1024, nb * 32, 1024, kb * 64, WSP(bf16_t, WS_WOUT) + (size_t)l * 1024 * 1024, nb * 32, scr, lane); continue; }
        r -= IT_WOUT;
        if (r < IT_W1) { const int le = r / 1024, q = r % 1024, kb = q / 64, nb = q % 64, n0 = nb * 32;
            const int drow = n0 < 1024 ? 256 * (n0 / 128) + (n0 % 128) : 256 * ((n0 - 1024) / 128) + 128 + ((n0 - 1024) % 128);
            transpose_item(p.in[I_W1] + (size_t)le * 1024 * 2048, 2048, n0, 2048, kb * 64, WSP(bf16_t, WS_W1) + (size_t)le * 2048 * 1024, drow, scr, lane); continue; }
        r -= IT_W1;
        { const int le = r / 512, q = r % 512, kb = q / 32, nb = q % 32;
            transpose_item(p.in[I_W2] + (size_t)le * 1024 * 1024, 1024, nb * 32, 1024, kb * 64, WSP(bf16_t, WS_W2) + (size_t)le * 1024 * 1024, nb * 32, scr, lane); }
    }
}

__device__ __forceinline__ void norm_mod_store(const f32x4 (&v)[4], const float* g, const float* shift, const float* scale, bf16_t* orow, int lane) {
    float ss = 0.f;
#pragma unroll
    for (int j = 0; j < 4; ++j) ss += (v[j][0] * v[j][0] + v[j][1] * v[j][1]) + (v[j][2] * v[j][2] + v[j][3] * v[j][3]);
    const float rstd = rsqrtf(wsum(ss) * (1.f / 1024.f) + 1e-6f);
#pragma unroll
    for (int j = 0; j < 4; ++j) { const int k = 4 * (lane + 64 * j);
        const f32x4 gg = *(const f32x4*)(g + k), sh = *(const f32x4*)(shift + k), sc = *(const f32x4*)(scale + k);
        const f32x4 o = (v[j] * rstd * gg) * (sc + 1.f) + sh;
        u32x2 w; w.x = pk2(o[0], o[1]); w.y = pk2(o[2], o[3]); *(u32x2*)(orow + k) = w; }
}
__device__ __forceinline__ void phase_norm1(const KP& p, int l, const float* xlat, const float* xctx) {
    const int lane = threadIdx.x & 63, wave = threadIdx.x >> 6, gw = blockIdx.x * NWAVES + wave, ngw = gridDim.x * NWAVES;
    const float* g = p.in[I_N1G] + l * 1024; const float* MOD = WSP(float, WS_MOD) + (size_t)l * 5 * 6144; bf16_t* H = WSP(bf16_t, WS_H);
    for (int m = gw; m < NTOK; m += ngw) {
        const float* xr = m < NLAT ? xlat + (size_t)m * D : xctx + (size_t)(m - NLAT) * D; const int mr = m < NLAT ? (m >> 13) : 4;
        f32x4 v[4];
#pragma unroll
        for (int j = 0; j < 4; ++j) v[j] = *(const f32x4*)(xr + 4 * (lane + 64 * j));
        norm_mod_store(v, g, MOD + mr * 6144, MOD + mr * 6144 + 1024, H + (size_t)m * D, lane);
    }
}

__device__ __forceinline__ void seq_info(int m, int& pos, int& len) { if (m < NLAT) { pos = m & (T - 1); len = T; } else { pos = (m - NLAT) & (LC - 1); len = LC; } }
__device__ __forceinline__ f32x4 ld4bf(const bf16_t* ptr) { const u32x2 w = *(const u32x2*)ptr; return (f32x4){bflo(w.x), bfhi(w.x), bflo(w.y), bfhi(w.y)}; }
__device__ __forceinline__ void st4bf(bf16_t* ptr, f32x4 v) { u32x2 w; w.x = pk2(v[0], v[1]); w.y = pk2(v[2], v[3]); *(u32x2*)ptr = w; }

__device__ __forceinline__ void phase_prep(const KP& p, int l, LAS unsigned char* lds) {
    const int tid = threadIdx.x, lane = tid & 63, wave = tid >> 6;
    const int gw = blockIdx.x * NWAVES + wave, ngw = gridDim.x * NWAVES;
    const int gt = blockIdx.x * NTHR + tid, ngt = gridDim.x * NTHR;
    const bf16_t* U = WSP(bf16_t, WS_U);
    { const float* RT = WSP(float, WS_ROPE); bf16_t* QR = WSP(bf16_t, WS_QR); bf16_t* KR = WSP(bf16_t, WS_KR);
      for (int idx = gt; idx < NTOK * 320; idx += ngt) {
        const int m = idx / 320, r = idx % 320, hh = r >> 5, a = (r >> 4) & 1, f = r & 15;
        const int col = (hh < 8 ? hh * 64 : 512 + (hh - 8) * 64) + a * 32 + f;
        const float x1 = bf2f(U[(size_t)m * INP + col]), x2 = bf2f(U[(size_t)m * INP + col + 16]);
        float o1 = x1, o2 = x2;
        if (m < NLAT) { const int t = m & (T - 1); const int pos = a == 0 ? (t >> 6) : (t & 63); const float c = RT[(pos * 16 + f) * 2], s = RT[(pos * 16 + f) * 2 + 1]; o1 = x1 * c - x2 * s; o2 = x2 * c + x1 * s; }
        if (hh < 8) { bf16_t* d = QR + (size_t)m * 512 + hh * 64 + a * 32 + f; d[0] = (bf16_t)f2bf(o1 * 0.125f); d[16] = (bf16_t)f2bf(o2 * 0.125f); }
        else { bf16_t* d = KR + (size_t)m * 128 + (hh - 8) * 64 + a * 32 + f; d[0] = (bf16_t)f2bf(o1); d[16] = (bf16_t)f2bf(o2); }
      } }
    { const float* cw = p.in[I_MCONV] + (size_t)l * 3 * 512; float* MQ = WSP(float, WS_MQ); float* MK = WSP(float, WS_MK); float* GT = WSP(float, WS_GT);
      for (int idx = gt; idx < NTOK * 128; idx += ngt) {
        const int m = idx >> 7, c4 = (idx & 127) * 4; int pos, len; seq_info(m, pos, len);
        const bf16_t* up = U + (size_t)m * INP + UC_ML + c4;
        const f32x4 x1 = ld4bf(up); const f32x4 z = (f32x4){0.f, 0.f, 0.f, 0.f};
        const f32x4 x0 = pos > 0 ? ld4bf(up - INP) : z; const f32x4 x2 = pos < len - 1 ? ld4bf(up + INP) : z;
        const f32x4 w0 = *(const f32x4*)(cw + c4), w1 = *(const f32x4*)(cw + 512 + c4), w2 = *(const f32x4*)(cw + 1024 + c4);
        f32x4 y = x0 * w0 + x1 * w1 + x2 * w2;
#pragma unroll
        for (int i = 0; i < 4; ++i) y[i] = y[i] * sigm(y[i]);
        if (c4 < 256) *(f32x4*)(MQ + (size_t)m * 256 + c4) = y; else *(f32x4*)(MK + (size_t)m * 256 + c4 - 256) = y * 0.125f;
      }
      const float* gb = p.in[I_MGB] + l * 16;
      for (int idx = gt; idx < NTOK * 16; idx += ngt) { const int m = idx >> 4, gi = idx & 15;
        float v = bf2f(U[(size_t)m * INP + UC_ML + 1024 + gi]) + gb[gi];
        if ((gi >> 2) & 1) v = v > 0.f ? -log1pf(__expf(-v)) : v - log1pf(__expf(v));
        GT[idx] = v; } }
    { LAS float* sx = (LAS float*)lds + wave * (4 * 224);
      const float* cw = p.in[I_RCONV] + (size_t)l * 3 * 960;
      const float* w0p = p.in[I_RW0] + l * 512; const float* wup = p.in[I_RWUP] + (size_t)l * 2 * 32 * 256;
      const float* a0p = p.in[I_RA0] + l * 512; const float* aup = p.in[I_RAUP] + (size_t)l * 2 * 32 * 256;
      const float* gup = p.in[I_RGUP] + (size_t)l * 64 * 256;
      const float* kkw = p.in[I_RKK] + l * 256; const float* kaw = p.in[I_RKA] + l * 256;
      const float* v0p = p.in[I_RV0]; const float* vup = p.in[I_RVUP];
      float* VF = WSP(float, WS_VF);
      const int c4 = lane * 4;
      for (int grp = gw; grp < NTOK / 4; grp += ngw) {
        const int m0 = grp * 4; int pos0, len; seq_info(m0, pos0, len);
        const bool hp = pos0 > 0, hn = pos0 + 4 < len;
        f32x4 cv[4][3];
        { f32x4 raw[6][3];
#pragma unroll
          for (int j = 0; j < 6; ++j) { const bool ok = (j == 0) ? hp : ((j == 5) ? hn : true);
#pragma unroll
            for (int g = 0; g < 3; ++g) raw[j][g] = ok ? ld4bf(U + (size_t)(m0 - 1 + j) * INP + UC_RW + g * 256 + c4) : (f32x4){0.f, 0.f, 0.f, 0.f}; }
#pragma unroll
          for (int g = 0; g < 3; ++g) { const f32x4 k0 = *(const f32x4*)(cw + g * 256 + c4), k1 = *(const f32x4*)(cw + 960 + g * 256 + c4), k2 = *(const f32x4*)(cw + 1920 + g * 256 + c4);
#pragma unroll
            for (int tk = 0; tk < 4; ++tk) cv[tk][g] = raw[tk][g] * k0 + raw[tk + 1][g] * k1 + raw[tk + 2][g] * k2; } }
#pragma unroll
        for (int g = 0; g < 3; ++g) { const int col = 768 + 64 * g + lane; float x[6];
#pragma unroll
          for (int j = 0; j < 6; ++j) { const bool ok = (j == 0) ? hp : ((j == 5) ? hn : true); x[j] = ok ? bf2f(U[(size_t)(m0 - 1 + j) * INP + UC_RW + col]) : 0.f; }
          const float k0 = cw[col], k1 = cw[960 + col], k2 = cw[1920 + col];
#pragma unroll
          for (int tk = 0; tk < 4; ++tk) { float val = x[tk] * k0 + x[tk + 1] * k1 + x[tk + 2] * k2; if (g == 0) val = tanhf(val); if (g == 2) val = sigm(val); sx[tk * 224 + g * 64 + lane] = val; } }
        if (l == 1 && lane < 32) {
#pragma unroll
          for (int tk = 0; tk < 4; ++tk) sx[tk * 224 + 192 + lane] = bf2f(U[(size_t)(m0 + tk) * INP + UC_HV + lane]); }
        LDS_FENCE();
        const f32x4 kk_w = *(const f32x4*)(kkw + c4), ka_w = *(const f32x4*)(kaw + c4);
#pragma unroll
        for (int tk = 0; tk < 4; ++tk) { const size_t o = (size_t)(m0 + tk) * 256 + c4;
          *(f32x4*)(RWA(RA_R) + o) = cv[tk][0];
          const f32x4 kkr = cv[tk][1] * kk_w; float ss = (kkr[0] * kkr[0] + kkr[1] * kkr[1]) + (kkr[2] * kkr[2] + kkr[3] * kkr[3]); ss = gsum16(ss);
          const float inv = 1.f / fmaxf(sqrtf(ss), 1e-12f);
          *(f32x4*)(RWA(RA_KK) + o) = kkr * inv; }
        for (int d = 0; d < 2; ++d) {
          f32x4 acc[4];
#pragma unroll
          for (int tk = 0; tk < 4; ++tk) acc[tk] = *(const f32x4*)(w0p + d * 256 + c4);
#pragma unroll 4
          for (int j = 0; j < 32; ++j) { const f32x4 wr_ = *(const f32x4*)(wup + (size_t)(d * 32 + j) * 256 + c4);
#pragma unroll
            for (int tk = 0; tk < 4; ++tk) acc[tk] += wr_ * sx[tk * 224 + d * 32 + j]; }
#pragma unroll
          for (int tk = 0; tk < 4; ++tk) { f32x4 lw;
#pragma unroll
            for (int i = 0; i < 4; ++i) lw[i] = -0.6065306597126334f * sigm(acc[tk][i]);
            *(f32x4*)(RWA(RA_LW0 + d) + (size_t)(m0 + tk) * 256 + c4) = lw; }
#pragma unroll
          for (int tk = 0; tk < 4; ++tk) acc[tk] = *(const f32x4*)(a0p + d * 256 + c4);
#pragma unroll 4
          for (int j = 0; j < 32; ++j) { const f32x4 ar_ = *(const f32x4*)(aup + (size_t)(d * 32 + j) * 256 + c4);
#pragma unroll
            for (int tk = 0; tk < 4; ++tk) acc[tk] += ar_ * sx[tk * 224 + 64 + d * 32 + j]; }
#pragma unroll
          for (int tk = 0; tk < 4; ++tk) { f32x4 a, kd;
#pragma unroll
            for (int i = 0; i < 4; ++i) { a[i] = sigm(acc[tk][i]); kd[i] = cv[tk][1][i] * (1.f + (a[i] - 1.f) * ka_w[i]); }
            *(f32x4*)(RWA(RA_A0 + d) + (size_t)(m0 + tk) * 256 + c4) = a; *(f32x4*)(RWA(RA_KD0 + d) + (size_t)(m0 + tk) * 256 + c4) = kd; }
        }
        { f32x4 acc[4];
#pragma unroll
          for (int tk = 0; tk < 4; ++tk) acc[tk] = (f32x4){0.f, 0.f, 0.f, 0.f};
#pragma unroll 4
          for (int j = 0; j < 64; ++j) { const f32x4 gr_ = *(const f32x4*)(gup + (size_t)j * 256 + c4);
#pragma unroll
            for (int tk = 0; tk < 4; ++tk) acc[tk] += gr_ * sx[tk * 224 + 128 + j]; }
#pragma unroll
          for (int tk = 0; tk < 4; ++tk) *(f32x4*)(RWA(RA_G) + (size_t)(m0 + tk) * 256 + c4) = acc[tk]; }
        if (l == 0) {
#pragma unroll
          for (int tk = 0; tk < 4; ++tk) { const size_t o = (size_t)(m0 + tk) * 256 + c4; *(f32x4*)(VF + o) = cv[tk][2]; *(f32x4*)(RWA(RA_V) + o) = cv[tk][2]; }
        } else { f32x4 acc[4];
#pragma unroll
          for (int tk = 0; tk < 4; ++tk) acc[tk] = *(const f32x4*)(v0p + c4);
#pragma unroll 4
          for (int j = 0; j < 32; ++j) { const f32x4 vr_ = *(const f32x4*)(vup + (size_t)j * 256 + c4);
#pragma unroll
            for (int tk = 0; tk < 4; ++tk) acc[tk] += vr_ * sx[tk * 224 + 192 + j]; }
#pragma unroll
          for (int tk = 0; tk < 4; ++tk) { const size_t o = (size_t)(m0 + tk) * 256 + c4; const f32x4 vf = *(const f32x4*)(VF + o); f32x4 v = cv[tk][2];
#pragma unroll
            for (int i = 0; i < 4; ++i) v[i] = v[i] + (vf[i] - v[i]) * sigm(acc[tk][i]);
            *(f32x4*)(RWA(RA_V) + o) = v; } }
        LDS_FENCE();
      } }
}

__device__ __forceinline__ void rwkv_chain(const KP& p, int l, int chain, int lane) {
    const int d = chain & 1, h = (chain >> 1) & 3, b = chain >> 3;
    const float* LW = RWA(RA_LW0 + d); const float* AA = RWA(RA_A0 + d); const float* KD = RWA(RA_KD0 + d);
    const float* KK = RWA(RA_KK); const float* RR = RWA(RA_R); const float* VV = RWA(RA_V); float* Y = RWA(RA_Y0 + d);
    float S[64];
#pragma unroll
    for (int k = 0; k < 64; ++k) S[k] = 0.f;
    const int co = h * 64 + lane;
    for (int seg = 0; seg < 2; ++seg) {
        const int n = seg == 0 ? LC : T; const int base = seg == 0 ? NLAT + b * LC : b * T;
        const bool emit = (seg == 1) || (l == 0);
        float cur[8][6], nxt[8][6];
#pragma unroll
        for (int s = 0; s < 8; ++s) { const int pos = d ? n - 1 - s : s; const size_t o = (size_t)(base + pos) * 256 + co;
            cur[s][0] = LW[o]; cur[s][1] = KD[o]; cur[s][2] = VV[o]; cur[s][3] = KK[o]; cur[s][4] = AA[o]; cur[s][5] = RR[o]; }
        for (int g = 0; g < n / 8; ++g) {
            if (g + 1 < n / 8) {
#pragma unroll
                for (int s = 0; s < 8; ++s) { const int st = (g + 1) * 8 + s; const int pos = d ? n - 1 - st : st; const size_t o = (size_t)(base + pos) * 256 + co;
                    nxt[s][0] = LW[o]; nxt[s][1] = KD[o]; nxt[s][2] = VV[o]; nxt[s][3] = KK[o]; nxt[s][4] = AA[o]; nxt[s][5] = RR[o]; }
            }
#pragma unroll
            for (int s = 0; s < 8; ++s) {
                const float wv = __expf(cur[s][0]), kdv = cur[s][1], vv = cur[s][2], kkv = cur[s][3], kka = cur[s][3] * cur[s][4], rv = cur[s][5];
                float s0 = 0.f, s1 = 0.f, s2 = 0.f, s3 = 0.f;
#pragma unroll
                for (int k = 0; k < 64; k += 4) { s0 += S[k] * rlane(kkv, k); s1 += S[k + 1] * rlane(kkv, k + 1); s2 += S[k + 2] * rlane(kkv, k + 2); s3 += S[k + 3] * rlane(kkv, k + 3); }
                const float nsa = -((s0 + s1) + (s2 + s3));
                float y0 = 0.f, y1 = 0.f, y2 = 0.f, y3 = 0.f;
#pragma unroll
                for (int k = 0; k < 64; k += 4) {
                    S[k] = S[k] * rlane(wv, k) + nsa * rlane(kka, k) + vv * rlane(kdv, k); y0 += S[k] * rlane(rv, k);
                    S[k + 1] = S[k + 1] * rlane(wv, k + 1) + nsa * rlane(kka, k + 1) + vv * rlane(kdv, k + 1); y1 += S[k + 1] * rlane(rv, k + 1);
                    S[k + 2] = S[k + 2] * rlane(wv, k + 2) + nsa * rlane(kka, k + 2) + vv * rlane(kdv, k + 2); y2 += S[k + 2] * rlane(rv, k + 2);
                    S[k + 3] = S[k + 3] * rlane(wv, k + 3) + nsa * rlane(kka, k + 3) + vv * rlane(kdv, k + 3); y3 += S[k + 3] * rlane(rv, k + 3); }
                if (emit) { const int st = g * 8 + s; const int pos = d ? n - 1 - st : st; Y[(size_t)(base + pos) * 256 + co] = (y0 + y1) + (y2 + y3); }
            }
#pragma unroll
            for (int s = 0; s < 8; ++s)
#pragma unroll
                for (int q = 0; q < 6; ++q) cur[s][q] = nxt[s][q];
        }
    }
}
__device__ __forceinline__ void mlstm_chain(const KP& p, int l, int chain, int lane) {
    const int d = chain & 1, h = (chain >> 1) & 3, b = chain >> 3;
    const float* MQ = WSP(float, WS_MQ); const float* MK = WSP(float, WS_MK); const float* GT = WSP(float, WS_GT);
    const bf16_t* U = WSP(bf16_t, WS_U); float* MO = WSP(float, d ? WS_MO1 : WS_MO0);
    float C[64];
#pragma unroll
    for (int k = 0; k < 64; ++k) C[k] = 0.f;
    float nn = 0.f;
    const int co = h * 64 + lane;
    for (int seg = 0; seg < 2; ++seg) {
        const int n = seg == 0 ? LC : T; const int base = seg == 0 ? NLAT + b * LC : b * T;
        const bool emit = (seg == 1) || (l == 0);
        float cur[8][5], nxt[8][5];
#pragma unroll
        for (int s = 0; s < 8; ++s) { const int pos = d ? n - 1 - s : s; const size_t m = (size_t)(base + pos);
            cur[s][0] = MQ[m * 256 + co]; cur[s][1] = MK[m * 256 + co]; cur[s][2] = bf2f(U[m * INP + UC_ML + 512 + co]); cur[s][3] = GT[m * 16 + d * 8 + h]; cur[s][4] = GT[m * 16 + d * 8 + 4 + h]; }
        for (int g = 0; g < n / 8; ++g) {
            if (g + 1 < n / 8) {
#pragma unroll
                for (int s = 0; s < 8; ++s) { const int st = (g + 1) * 8 + s; const int pos = d ? n - 1 - st : st; const size_t m = (size_t)(base + pos);
                    nxt[s][0] = MQ[m * 256 + co]; nxt[s][1] = MK[m * 256 + co]; nxt[s][2] = bf2f(U[m * INP + UC_ML + 512 + co]); nxt[s][3] = GT[m * 16 + d * 8 + h]; nxt[s][4] = GT[m * 16 + d * 8 + 4 + h]; }
            }
#pragma unroll
            for (int s = 0; s < 8; ++s) {
                const float qv = cur[s][0], f = __expf(cur[s][4]), ikv = __expf(cur[s][3]) * cur[s][1], vv = cur[s][2];
                float y0 = 0.f, y1 = 0.f, y2 = 0.f, y3 = 0.f;
#pragma unroll
                for (int k = 0; k < 64; k += 4) {
                    C[k] = f * C[k] + rlane(ikv, k) * vv; y0 += rlane(qv, k) * C[k];
                    C[k + 1] = f * C[k + 1] + rlane(ikv, k + 1) * vv; y1 += rlane(qv, k + 1) * C[k + 1];
                    C[k + 2] = f * C[k + 2] + rlane(ikv, k + 2) * vv; y2 += rlane(qv, k + 2) * C[k + 2];
                    C[k + 3] = f * C[k + 3] + rlane(ikv, k + 3) * vv; y3 += rlane(qv, k + 3) * C[k + 3]; }
                nn = f * nn + ikv;
                const float den = wsum(qv * nn);
                if (emit) { const int st = g * 8 + s; const int pos = d ? n - 1 - st : st; MO[(size_t)(base + pos) * 256 + co] = ((y0 + y1) + (y2 + y3)) / fmaxf(fabsf(den), 1.f); }
            }
#pragma unroll
            for (int s = 0; s < 8; ++s)
#pragma unroll
                for (int q = 0; q < 5; ++q) cur[s][q] = nxt[s][q];
        }
    }
}
__device__ __forceinline__ void attn_item(const KP& p, int l, int item, LAS float* sc, int lane) {
    const int m = item >> 3, hq = item & 7, kvh = hq >> 2;
    const bf16_t* QR = WSP(bf16_t, WS_QR); const bf16_t* KR = WSP(bf16_t, WS_KR); const bf16_t* U = WSP(bf16_t, WS_U); bf16_t* MIX = WSP(bf16_t, WS_MIX);
    int b, nloc, lo;
    if (m < NLAT) { b = m >> 13; const int t = m & (T - 1); lo = t - 128 < 0 ? 0 : t - 128; const int hi = t + 128 > T - 1 ? T - 1 : t + 128; nloc = hi - lo + 1; }
    else { b = (m - NLAT) >> 8; nloc = 0; lo = 0; }
    const int nk = nloc + LC;
    float q[64];
    { const u32x4* qp = (const u32x4*)(QR + (size_t)m * 512 + hq * 64);
#pragma unroll
      for (int c = 0; c < 8; ++c) { const u32x4 w = qp[c]; q[8 * c] = bflo(w.x); q[8 * c + 1] = bfhi(w.x); q[8 * c + 2] = bflo(w.y); q[8 * c + 3] = bfhi(w.y); q[8 * c + 4] = bflo(w.z); q[8 * c + 5] = bfhi(w.z); q[8 * c + 6] = bflo(w.w); q[8 * c + 7] = bfhi(w.w); } }
    const float sink = p.in[I_SINK][l * 8 + hq];
    float mx = sink;
    for (int i = 0; i < 9; ++i) { const int kidx = lane + 64 * i;
        if (kidx < nk) { const int row = kidx < nloc ? b * T + lo + kidx : NLAT + b * LC + (kidx - nloc);
            const u32x4* kp = (const u32x4*)(KR + (size_t)row * 128 + kvh * 64); float s = 0.f;
#pragma unroll
            for (int c = 0; c < 8; ++c) { const u32x4 w = kp[c]; s += q[8 * c] * bflo(w.x) + q[8 * c + 1] * bfhi(w.x) + q[8 * c + 2] * bflo(w.y) + q[8 * c + 3] * bfhi(w.y) + q[8 * c + 4] * bflo(w.z) + q[8 * c + 5] * bfhi(w.z) + q[8 * c + 6] * bflo(w.w) + q[8 * c + 7] * bfhi(w.w); }
            sc[kidx] = s; mx = fmaxf(mx, s); } }
    mx = wmax(mx);
    float sum = 0.f;
    for (int i = 0; i < 9; ++i) { const int kidx = lane + 64 * i; if (kidx < nk) { const float e = __expf(sc[kidx] - mx); sc[kidx] = e; sum += e; } }
    sum = wsum(sum) + __expf(sink - mx);
    LDS_FENCE();
    const float inv = 1.f / sum;
    const bf16_t* Vb = U + UC_V + kvh * 64 + lane;
    float o0 = 0.f, o1 = 0.f;
    const bf16_t* vl = Vb + (size_t)(b * T + lo) * INP; const bf16_t* vc = Vb + (size_t)(NLAT + b * LC) * INP;
    int j = 0;
    for (; j + 1 < nloc; j += 2) { o0 += sc[j] * bf2f(vl[(size_t)j * INP]); o1 += sc[j + 1] * bf2f(vl[(size_t)(j + 1) * INP]); }
    if (j < nloc) o0 += sc[j] * bf2f(vl[(size_t)j * INP]);
    for (int jj = 0; jj < LC; jj += 2) { o0 += sc[nloc + jj] * bf2f(vc[(size_t)jj * INP]); o1 += sc[nloc + jj + 1] * bf2f(vc[(size_t)(jj + 1) * INP]); }
    MIX[(size_t)m * 1024 + hq * 64 + lane] = (bf16_t)f2bf((o0 + o1) * inv);
    LDS_FENCE();
}
__device__ __forceinline__ void phase_scan_attn(const KP& p, int l, LAS unsigned char* lds) {
    const int tid = threadIdx.x, lane = tid & 63, wave = tid >> 6;
    if (wave == 0 && (blockIdx.x & 3) == 0) { const int c = blockIdx.x >> 2;
        if (c < 32) rwkv_chain(p, l, c, lane); else if (c < 64) mlstm_chain(p, l, c - 32, lane); }
    LAS float* sc = (LAS float*)lds + wave * 640;
    unsigned* ctr = WSP(unsigned, WS_CTL) + CW_ATT + l * 64;
    const int nitems = (l == 0 ? NTOK : NLAT) * 8;
    for (;;) { int it = 0; if (lane == 0) it = (int)atomicAdd(ctr, 1u); it = __builtin_amdgcn_readfirstlane(it); if (it >= nitems) break; attn_item(p, l, it, sc, lane); }
}

__device__ __forceinline__ void phase_merge(const KP& p, int l) {
    const int lane = threadIdx.x & 63, wave = threadIdx.x >> 6, gw = blockIdx.x * NWAVES + wave, ngw = gridDim.x * NWAVES;
    const int c4 = lane * 4; const int mhi = l == 0 ? NTOK : NLAT;
    const bf16_t* U = WSP(bf16_t, WS_U); bf16_t* MIX = WSP(bf16_t, WS_MIX);
    const f32x4 rk = *(const f32x4*)(p.in[I_RRK] + l * 256 + c4), lnw = *(const f32x4*)(p.in[I_RLNW] + l * 256 + c4), lnb = *(const f32x4*)(p.in[I_RLNB] + l * 256 + c4);
    const f32x4 mlw = *(const f32x4*)(p.in[I_MLNW] + l * 256 + c4);
    for (int m = gw; m < mhi; m += ngw) { const size_t o = (size_t)m * 256 + c4;
        const f32x4 r = *(const f32x4*)(RWA(RA_R) + o), v = *(const f32x4*)(RWA(RA_V) + o), g = *(const f32x4*)(RWA(RA_G) + o);
        f32x4 acc = (f32x4){0.f, 0.f, 0.f, 0.f};
#pragma unroll
        for (int d = 0; d < 2; ++d) { const f32x4 y = *(const f32x4*)(RWA(RA_Y0 + d) + o), kd = *(const f32x4*)(RWA(RA_KD0 + d) + o);
            const float mu = gsum16((y[0] + y[1]) + (y[2] + y[3])) * (1.f / 64.f); const f32x4 yc = y - mu;
            const float var = gsum16((yc[0] * yc[0] + yc[1] * yc[1]) + (yc[2] * yc[2] + yc[3] * yc[3])) * (1.f / 64.f);
            const float rs = rsqrtf(var + 64e-5f);
            const float bs = gsum16((r[0] * kd[0] * rk[0] + r[1] * kd[1] * rk[1]) + (r[2] * kd[2] * rk[2] + r[3] * kd[3] * rk[3]));
            acc += yc * rs * lnw + lnb + v * bs; }
        st4bf(MIX + (size_t)m * 1024 + 512 + c4, acc * g);
        const f32x4 hs = *(const f32x4*)(WSP(float, WS_MO0) + o) + *(const f32x4*)(WSP(float, WS_MO1) + o);
        const float mu = gsum16((hs[0] + hs[1]) + (hs[2] + hs[3])) * (1.f / 64.f); const f32x4 hc = hs - mu;
        const float var = gsum16((hc[0] * hc[0] + hc[1] * hc[1]) + (hc[2] * hc[2] + hc[3] * hc[3])) * (1.f / 64.f);
        const float rs = rsqrtf(var + 1e-5f);
        const f32x4 og = ld4bf(U + (size_t)m * INP + UC_ML + 768 + c4);
        f32x4 out;
#pragma unroll
        for (int i = 0; i < 4; ++i) out[i] = hc[i] * rs * mlw[i] * sigm(og[i]);
        st4bf(MIX + (size_t)m * 1024 + 768 + c4, out);
    }
}

__device__ __forceinline__ void phase_router(const KP& p, int l) {
    const int lane = threadIdx.x & 63, wave = threadIdx.x >> 6, gw = blockIdx.x * NWAVES + wave, ngw = gridDim.x * NWAVES;
    const int mhi = l == 0 ? NTOK : NLAT;
    const float* g = p.in[I_N2G] + l * 1024; const float* MOD = WSP(float, WS_MOD) + (size_t)l * 5 * 6144;
    const float* X = WSP(float, WS_X); bf16_t* H = WSP(bf16_t, WS_H);
    const float* RW = p.in[I_ROUTW] + (size_t)l * 1024 * 32; const float* RB = p.in[I_ROUTB] + l * 32;
    unsigned* cnt = WSP(unsigned, WS_CTL) + CW_CNT + l * 32; int* list = WSP(int, WS_LIST); float* gates = WSP(float, WS_GATE);
    for (int m = gw; m < mhi; m += ngw) {
        const int mr = m < NLAT ? (m >> 13) : 4; const float* shift = MOD + mr * 6144 + 3 * 1024; const float* scale = MOD + mr * 6144 + 4 * 1024;
        f32x4 v[4]; float ss = 0.f;
#pragma unroll
        for (int j = 0; j < 4; ++j) { v[j] = *(const f32x4*)(X + (size_t)m * D + 4 * (lane + 64 * j)); ss += (v[j][0] * v[j][0] + v[j][1] * v[j][1]) + (v[j][2] * v[j][2] + v[j][3] * v[j][3]); }
        const float rstd = rsqrtf(wsum(ss) * (1.f / 1024.f) + 1e-6f);
        float lg[32];
#pragma unroll
        for (int e = 0; e < 32; ++e) lg[e] = 0.f;
#pragma unroll
        for (int j = 0; j < 4; ++j) { const int k = 4 * (lane + 64 * j);
            const f32x4 gg = *(const f32x4*)(g + k), sh = *(const f32x4*)(shift + k), sc = *(const f32x4*)(scale + k);
            const f32x4 o = (v[j] * rstd * gg) * (sc + 1.f) + sh;
            st4bf(H + (size_t)m * D + k, o);
#pragma unroll
            for (int i = 0; i < 4; ++i) { const f32x4* wr = (const f32x4*)(RW + (size_t)(k + i) * 32);
#pragma unroll
                for (int q = 0; q < 8; ++q) { const f32x4 w4 = wr[q]; lg[4 * q] += o[i] * w4[0]; lg[4 * q + 1] += o[i] * w4[1]; lg[4 * q + 2] += o[i] * w4[2]; lg[4 * q + 3] += o[i] * w4[3]; } } }
#pragma unroll
        for (int e = 0; e < 32; ++e) lg[e] = wsum(lg[e]) + RB[e];
        int sel[4]; float sv[4]; unsigned taken = 0u;
#pragma unroll
        for (int r = 0; r < 4; ++r) { float best = -INFINITY; int bi = 0;
#pragma unroll
            for (int e = 0; e < 32; ++e) { const bool ok = (((taken >> e) & 1u) == 0u) && (lg[e] > best); best = ok ? lg[e] : best; bi = ok ? e : bi; }
            sel[r] = bi; sv[r] = best; taken |= 1u << bi; }
        const float e1 = __expf(sv[1] - sv[0]), e2 = __expf(sv[2] - sv[0]), e3 = __expf(sv[3] - sv[0]); const float inv = 1.f / (1.f + e1 + e2 + e3);
        const float gv[4] = {inv, e1 * inv, e2 * inv, e3 * inv};
        if (lane == 0) {
#pragma unroll
            for (int r = 0; r < 4; ++r) { const unsigned slot = atomicAdd(cnt + sel[r], 1u); list[(size_t)sel[r] * CAP + slot] = m * 4 + r; gates[m * 4 + r] = gv[r]; } }
    }
}

__device__ __forceinline__ void phase_combine(const KP& p, int l) {
    const int lane = threadIdx.x & 63, wave = threadIdx.x >> 6, gw = blockIdx.x * NWAVES + wave, ngw = gridDim.x * NWAVES;
    const int mhi = l == 0 ? NTOK : NLAT;
    const float* MOD = WSP(float, WS_MOD) + (size_t)l * 5 * 6144; float* X = WSP(float, WS_X); const bf16_t* YK = WSP(bf16_t, WS_YK);
    for (int m = gw; m < mhi; m += ngw) {
        const int mr = m < NLAT ? (m >> 13) : 4; const float* g2 = MOD + mr * 6144 + 5 * 1024;
        f32x4 v[4];
#pragma unroll
        for (int j = 0; j < 4; ++j) { const int k = 4 * (lane + 64 * j); f32x4 s = (f32x4){0.f, 0.f, 0.f, 0.f};
#pragma unroll
            for (int r = 0; r < 4; ++r) s += ld4bf(YK + (size_t)(m * 4 + r) * 1024 + k);
            v[j] = *(const f32x4*)(X + (size_t)m * D + k) + *(const f32x4*)(g2 + k) * s; }
        if (l == 0) {
#pragma unroll
            for (int j = 0; j < 4; ++j) *(f32x4*)(X + (size_t)m * D + 4 * (lane + 64 * j)) = v[j];
            const float* MOD1 = WSP(float, WS_MOD) + (size_t)5 * 6144;
            norm_mod_store(v, p.in[I_N1G] + 1024, MOD1 + mr * 6144, MOD1 + mr * 6144 + 1024, WSP(bf16_t, WS_H) + (size_t)m * D, lane);
        } else {
            float ss = 0.f;
#pragma unroll
            for (int j = 0; j < 4; ++j) ss += (v[j][0] * v[j][0] + v[j][1] * v[j][1]) + (v[j][2] * v[j][2] + v[j][3] * v[j][3]);
            const float rstd = rsqrtf(wsum(ss) * (1.f / 1024.f) + 1e-6f);
#pragma unroll
            for (int j = 0; j < 4; ++j) { const int k = 4 * (lane + 64 * j); *(f32x4*)(p.out + (size_t)m * D + k) = v[j] * rstd * *(const f32x4*)(p.in[I_FNG] + k); }
        }
    }
}

__device__ __forceinline__ void moe_prefix(const KP& p, int l, LAS int* tp) {
    if (threadIdx.x == 0) { const unsigned* cnt = WSP(unsigned, WS_CTL) + CW_CNT + l * 32; int s = 0;
        for (int e = 0; e < 32; ++e) { tp[e] = s; s += ((int)cnt[e] + 255) >> 8; } tp[32] = s; }
    __syncthreads();
}

template <int PH> __global__ void __launch_bounds__(NTHR, 2) k_ph(KP p, int l) {
    extern __shared__ __attribute__((aligned(16))) unsigned char lds_raw[];
    LAS unsigned char* lds = (LAS unsigned char*)lds_raw;
    if constexpr (PH == 0) phase_p0a(p, lds);
    if constexpr (PH == 1) phase_norm1(p, 0, p.in[I_X], p.in[I_CTX]);
    if constexpr (PH == 2) {
        pg8::DenseOrder S; S.init(NTOK, INP, gridDim.x, blockIdx.x, WSP(bf16_t, WS_WIN) + (size_t)l * INP * 1024);
        pg8::EpiInProj E{WSP(bf16_t, WS_U)};
        pg8::gemm_phase(lds, WSP(const unsigned char, WS_H), S, E); }
    if constexpr (PH == 3) phase_prep(p, l, lds);
    if constexpr (PH == 4) phase_scan_attn(p, l, lds);
    if constexpr (PH == 5) phase_merge(p, l);
    if constexpr (PH == 6) {
        pg8::DenseOrder S; S.init(l == 0 ? NTOK : NLAT, D, gridDim.x, blockIdx.x, WSP(bf16_t, WS_WOUT) + (size_t)l * 1024 * 1024);
        pg8::EpiOutProj E{l == 0 ? p.in[I_X] : WSP(const float, WS_X), l == 0 ? p.in[I_CTX] : WSP(const float, WS_X) + (size_t)NLAT * D, WSP(float, WS_X), WSP(const float, WS_MOD) + (size_t)l * 5 * 6144};
        pg8::gemm_phase(lds, WSP(const unsigned char, WS_MIX), S, E); }
    if constexpr (PH == 7) phase_router(p, l);
    if constexpr (PH == 8) {
        LAS int* tp = (LAS int*)(lds + MISC_OFF); moe_prefix(p, l, tp);
        pg8::MoeOrder S{tp, WSP(const int, WS_LIST), WSP(const int, WS_CTL) + CW_CNT + l * 32, 8, (int)gridDim.x, (int)blockIdx.x, 2,
                        WSP(const unsigned char, WS_W1) + (size_t)l * 32 * 2048 * 1024 * 2, (size_t)2048 * 1024 * 2};
        pg8::EpiMoe1 E{WSP(const int, WS_LIST), p.in[I_B1] + (size_t)l * 32 * 2048, WSP(bf16_t, WS_HB)};
        pg8::gemm_phase(lds, WSP(const unsigned char, WS_H), S, E); }
    if constexpr (PH == 9) {
        LAS int* tp = (LAS int*)(lds + MISC_OFF); moe_prefix(p, l, tp);
        pg8::MoeOrder S{tp, WSP(const int, WS_LIST), WSP(const int, WS_CTL) + CW_CNT + l * 32, 4, (int)gridDim.x, (int)blockIdx.x, 0,
                        WSP(const unsigned char, WS_W2) + (size_t)l * 32 * 1024 * 1024 * 2, (size_t)1024 * 1024 * 2};
        pg8::EpiMoe2 E{WSP(const int, WS_LIST), p.in[I_B2] + (size_t)l * 32 * 1024, WSP(const float, WS_GATE), WSP(bf16_t, WS_YK)};
        pg8::gemm_phase(lds, WSP(const unsigned char, WS_HB), S, E); }
    if constexpr (PH == 10) phase_combine(p, l);
}

template <int PH> static void launch_ph(const KP& p, int l, int grid, hipStream_t stream) {
    static bool attr = false;
    if (!attr) { (void)hipFuncSetAttribute((const void*)k_ph<PH>, hipFuncAttributeMaxDynamicSharedMemorySize, LDS_BYTES); attr = true; }
    hipLaunchKernelGGL(k_ph<PH>, dim3(grid), dim3(NTHR), LDS_BYTES, stream, p, l);
}
extern "C" void kernel_launch(void* const* d_in, const int* in_sizes, int n_in, void* d_out, int out_size, void* d_ws, size_t ws_size, hipStream_t stream) {
    static int grid = 0;
    if (grid == 0) {
        if (n_in != 35 || out_size != NLAT * D || ws_size < WS_END) { fprintf(stderr, "kernel_launch: unexpected sizes n_in %d out %d ws %zu (need %zu)\n", n_in, out_size, ws_size, (size_t)WS_END); grid = -1; return; }
        int dev = 0, cus = 0;
        (void)hipGetDevice(&dev); (void)hipDeviceGetAttribute(&cus, hipDeviceAttributeMultiprocessorCount, dev);
        grid = cus > 0 ? cus : 256;
        (void)hipGetLastError();
    }
    if (grid < 0) return;
    (void)hipMemsetAsync((char*)d_ws + WS_CTL, 0, CTL_ZERO_BYTES, stream);
    KP p{};
    for (int i = 0; i < 35; ++i) p.in[i] = (const float*)d_in[i];
    p.out = (float*)d_out; p.ws = (unsigned char*)d_ws;
    launch_ph<0>(p, 0, grid, stream);
    launch_ph<1>(p, 0, grid, stream);
    for (int l = 0; l < 2; ++l) {
        launch_ph<2>(p, l, grid, stream); launch_ph<3>(p, l, grid, stream); launch_ph<4>(p, l, grid, stream); launch_ph<5>(p, l, grid, stream); launch_ph<6>(p, l, grid, stream);
        launch_ph<7>(p, l, grid, stream); launch_ph<8>(p, l, grid, stream); launch_ph<9>(p, l, grid, stream); launch_ph<10>(p, l, grid, stream);
    }
}
```

```cpp
#include <hip/hip_runtime.h>
#include <hip/hip_cooperative_groups.h>
#include <cstdio>
#include <cstdint>
namespace cg = cooperative_groups;

#define LAS __attribute__((address_space(3)))
typedef unsigned short bf16_t;
typedef unsigned u32x4 __attribute__((ext_vector_type(4)));
typedef unsigned u32x2 __attribute__((ext_vector_type(2)));
typedef float f32x4 __attribute__((ext_vector_type(4)));
typedef float f32x2 __attribute__((ext_vector_type(2)));
typedef short bf16x8 __attribute__((ext_vector_type(8)));
typedef float f32x16 __attribute__((ext_vector_type(16)));
typedef short s16x4 __attribute__((ext_vector_type(4)));

constexpr int D = 1024, NB = 4, T = 8192, LC = 256;
constexpr int NLAT = NB * T, NCTX = NB * LC, NTOK = NLAT + NCTX;
constexpr int INW = 2768, INP = 2816;
constexpr int UC_Q = 0, UC_K = 512, UC_V = 640, UC_RW = 768, UC_ML = 1728, UC_HV = 2784;
constexpr int NE = 32, CAP = NTOK;
constexpr int NWAVES = 8, NTHR = 512;
constexpr int LDS_BYTES = 147456;
constexpr float QSCALE = 0.125f * 1.4426950408889634f;
constexpr int MISC_OFF = 146432;

constexpr size_t MiB = 1u << 20;
constexpr size_t WS_CTL = 0, CTL_ZERO_BYTES = 65536;
constexpr size_t WS_MOD = 1 * MiB;
constexpr size_t WS_ROPE = 1 * MiB + 512 * 1024;
constexpr size_t WS_GATE = 2 * MiB;
constexpr size_t WS_LIST = 3 * MiB;
constexpr size_t WS_WIN = 8 * MiB;
constexpr size_t WS_WOUT = 20 * MiB;
constexpr size_t WS_W1 = 24 * MiB;
constexpr size_t WS_W2 = 280 * MiB;
constexpr size_t WS_X = 408 * MiB;
constexpr size_t WS_H = 540 * MiB;
constexpr size_t WS_MIX = 606 * MiB;
constexpr size_t WS_VF = 672 * MiB;
constexpr size_t WS_SCR = 706 * MiB;
constexpr size_t WS_U = WS_SCR;
constexpr size_t WS_QR = WS_SCR + 182 * MiB;
constexpr size_t WS_KR = WS_SCR + 215 * MiB;
constexpr size_t WS_RWA = WS_SCR + 224 * MiB;
constexpr size_t RWA_STRIDE = 33 * MiB;
enum { RA_R = 0, RA_V, RA_KK, RA_G, RA_LW0, RA_LW1, RA_A0, RA_A1, RA_KD0, RA_KD1, RA_Y0, RA_Y1 };
constexpr size_t WS_MQ = WS_SCR + 620 * MiB;
constexpr size_t WS_MK = WS_SCR + 653 * MiB;
constexpr size_t WS_GT = WS_SCR + 686 * MiB;
constexpr size_t WS_MO0 = WS_SCR + 689 * MiB;
constexpr size_t WS_MO1 = WS_SCR + 722 * MiB;
constexpr size_t WS_HB = WS_SCR;
constexpr size_t WS_YK = WS_SCR + 264 * MiB;
constexpr size_t WS_MLDC = WS_SCR + 758 * MiB;
constexpr size_t WS_MLCS = WS_SCR + 830 * MiB;
constexpr size_t WS_MLSM = WS_SCR + 866 * MiB;
constexpr size_t WS_MQB = WS_SCR + 870 * MiB;
constexpr size_t WS_MKB = WS_SCR + 887 * MiB;
constexpr size_t WS_RGH = WS_SCR + 904 * MiB;
constexpr size_t WS_RRW = WS_SCR + 1036 * MiB;
constexpr size_t WS_RYP = WS_SCR + 1069 * MiB;
constexpr size_t WS_RSC = WS_SCR + 1135 * MiB;
constexpr size_t WS_END = WS_SCR + 1168 * MiB;
constexpr int CW_CNT = 8192;
constexpr int CW_ATT = 128;

struct KP {
    const float* in[35];
    float* out;
    unsigned char* ws;
    int ph_lo, ph_hi;
};
enum { I_X = 0, I_C, I_CTX, I_CCTX, I_N1G, I_N2G, I_ADAW, I_ADAB, I_WIN, I_WOUT, I_SINK, I_RCONV, I_RW0, I_RWUP, I_RA0, I_RAUP, I_RGUP, I_RKK, I_RKA, I_RRK,
       I_RLNW, I_RLNB, I_RV0, I_RVDOWN, I_RVUP, I_MCONV, I_MGB, I_MLNW, I_ROUTW, I_ROUTB, I_W1, I_B1, I_W2, I_B2, I_FNG };

typedef const __attribute__((address_space(4))) KP* KPP;
__device__ __forceinline__ int otid() { int t = __builtin_amdgcn_workitem_id_x(); asm volatile("" : "+v"(t)); return t; }
__device__ __forceinline__ int obid() { int b = __builtin_amdgcn_workgroup_id_x(); asm volatile("" : "+s"(b)); return b; }
__device__ __forceinline__ KPP kp_ptr() { KPP q = (KPP)__builtin_amdgcn_kernarg_segment_ptr(); asm volatile("" : "+s"(q)); return q; }
typedef __bf16 hwbf16x2 __attribute__((ext_vector_type(2)));
__device__ __forceinline__ unsigned pk2(float lo, float hi) { const f32x2 v = {lo, hi}; const hwbf16x2 b = __builtin_convertvector(v, hwbf16x2); return __builtin_bit_cast(unsigned, b); }
__device__ __forceinline__ unsigned f2bf(float f) { return pk2(f, f) & 0xffffu; }
__device__ __forceinline__ float bf2f(bf16_t b) { return __uint_as_float(((unsigned)b) << 16); }
__device__ __forceinline__ float bflo(unsigned w) { return __uint_as_float(w << 16); }
__device__ __forceinline__ float bfhi(unsigned w) { return __uint_as_float(w & 0xffff0000u); }
__device__ __forceinline__ float sigm(float x) { return __builtin_amdgcn_rcpf(1.f + __expf(-x)); }
__device__ __forceinline__ float wsum(float v) {
#pragma unroll
    for (int o = 32; o; o >>= 1) v += __shfl_xor(v, o);
    return v;
}
__device__ __forceinline__ float wmax(float v) {
#pragma unroll
    for (int o = 32; o; o >>= 1) v = fmaxf(v, __shfl_xor(v, o));
    return v;
}
__device__ __forceinline__ float gsum16(float v) {
#pragma unroll
    for (int o = 8; o; o >>= 1) v += __shfl_xor(v, o);
    return v;
}
__device__ __forceinline__ float rlane(float x, int k) { return __int_as_float(__builtin_amdgcn_readlane(__float_as_int(x), k)); }
#define LDS_FENCE() asm volatile("s_waitcnt lgkmcnt(0)" ::: "memory")

#define XB_TMO      128
#define XB_XCNT(j)  (256  + 64 * (j))
#define XB_XSUB(j)  (1280 + 64 * (j))
#define XB_XGEN(j)  (2304 + 64 * (j))
#define XB_TOP      3328
#define XB_TOPGEN   3392
#define XCD_BAR_WORDS 3456
#define XB_SPIN_CAP (1u << 20)
constexpr int CW_BAR = 4096;
constexpr int BAR_ST_OFF = MISC_OFF + 256;
__device__ __forceinline__ unsigned xb_ld(unsigned* p)              { return __hip_atomic_load(p, __ATOMIC_RELAXED, __HIP_MEMORY_SCOPE_AGENT); }
__device__ __forceinline__ unsigned xb_add(unsigned* p, unsigned v) { return __hip_atomic_fetch_add(p, v, __ATOMIC_RELAXED, __HIP_MEMORY_SCOPE_AGENT); }
__device__ __forceinline__ unsigned xb_xcc_id() { return (unsigned)__builtin_amdgcn_s_getreg((3 << 11) | 20) & 0xFu; }
#define XB_SPIN(cond, bar) do { unsigned _sp = 0; while (cond) { __builtin_amdgcn_s_sleep(1); \
    if ((++_sp & 255u) == 0u) { if (xb_ld(&(bar)[XB_TMO])) break; if (_sp > XB_SPIN_CAP) { atomicAdd(&(bar)[XB_TMO], 1u); break; } } } } while (0)
__device__ __forceinline__ void xcd_barrier_post(unsigned* bar) { if (otid() == 0) (void)xb_add(&bar[XB_XCNT(xb_xcc_id())], 1u); }
__device__ __forceinline__ void xcd_barrier_complete(unsigned* bar, unsigned x, unsigned& nloc, unsigned& nx) {
    const unsigned G = gridDim.x;
    unsigned sum, cnt, mine, sp = 0u;
    for (;;) {
        sum = 0u; cnt = 0u; mine = 0u;
#pragma unroll
        for (unsigned j = 0; j < 16; ++j) { const unsigned c = xb_ld(&bar[XB_XCNT(j)]); sum += c; cnt += (c > 0u) ? 1u : 0u; mine = (j == x) ? c : mine; }
        if (sum == G) break;
        __builtin_amdgcn_s_sleep(1);
        if ((++sp & 255u) == 0u) { if (xb_ld(&bar[XB_TMO])) break; if (sp > XB_SPIN_CAP) { atomicAdd(&bar[XB_TMO], 1u); break; } }
    }
    nloc = mine > 0u ? mine : 1u; nx = cnt > 0u ? cnt : 1u;
}
__device__ __forceinline__ void xcd_barrier(unsigned* bar, LAS unsigned char* lds) {
    asm volatile("s_waitcnt vmcnt(0)" ::: "memory");
    __syncthreads();
    if (otid() == 0) {
        volatile LAS unsigned* st = (volatile LAS unsigned*)(lds + BAR_ST_OFF);
        const unsigned x = xb_xcc_id();
        __builtin_amdgcn_s_waitcnt(0);
        unsigned nloc = st[0], nx = st[1];
        if (nloc == 0u) { xcd_barrier_complete(bar, x, nloc, nx); st[0] = nloc; st[1] = nx; }
        const unsigned old = xb_add(&bar[XB_XSUB(x)], 1u);
        const unsigned gen = old / nloc;
        if (old + 1u == (gen + 1u) * nloc) {
            __builtin_amdgcn_fence(__ATOMIC_RELEASE, "agent");
            asm volatile("s_waitcnt vmcnt(0)" ::: "memory");
            const unsigned og = xb_add(&bar[XB_TOP], 1u);
            const unsigned tg = og / nx;
            if (og + 1u == (tg + 1u) * nx) xb_add(&bar[XB_TOPGEN], 1u);
            else XB_SPIN(xb_ld(&bar[XB_TOPGEN]) == tg, bar);
            __builtin_amdgcn_fence(__ATOMIC_ACQUIRE, "agent");
            xb_add(&bar[XB_XGEN(x)], 1u);
            asm volatile("s_waitcnt vmcnt(0)" ::: "memory");
        } else {
            XB_SPIN(xb_ld(&bar[XB_XGEN(x)]) == gen, bar);
            __builtin_amdgcn_fence(__ATOMIC_ACQUIRE, "agent");
            asm volatile("s_waitcnt vmcnt(0)" ::: "memory");
        }
    }
    __syncthreads();
}


namespace pg8 {
constexpr int BM = 256, BK = 64, HALF = 128, HTB = HALF * BK * 2, KD = 1024, NT = KD / BK;
__host__ __device__ __forceinline__ int lds_byte(int r, int c) { const int st = (r >> 4) * 2 + (c >> 5), rr = r & 15, cc = c & 31, ob = rr * 64 + cc * 2; return st * 1024 + (ob ^ (((ob >> 9) & 1) << 5)); }
__host__ __device__ __forceinline__ void stage_rc(int b, int& R, int& C) { const int st = b / 1024, sb = b % 1024, swz = sb ^ (((sb >> 9) & 1) << 5); R = (st >> 1) * 16 + swz / 64; C = (st & 1) * 32 + (swz % 64) / 2; }
__host__ __device__ __forceinline__ int perm32(int rho) { const int n = rho >> 4, i = rho & 15; return 8 * (i >> 2) + 4 * n + (i & 3); }
struct Unit { int pm, pn, e, rows; };

struct DenseOrder {
    int nM, nN, nwg, G, c; const unsigned char* Bt;
    __device__ void init(int M, int N, int G_, int c_, const void* Bt_) { nM = M / BM; nN = N / BM; nwg = nM * nN; G = G_; c = c_; Bt = (const unsigned char*)Bt_; }
    __device__ __forceinline__ bool next(int i, Unit& u) const {
        const long L = (long)i * G + c; if (L >= nwg) return false;
        int wgid = (int)L; { const int q = nwg / 8, r = nwg % 8, xcd = wgid % 8, off = wgid / 8; wgid = (xcd < r ? xcd * (q + 1) : r * (q + 1) + (xcd - r) * q) + off; }
        const int nig = 8 * nN, gid = wgid / nig, fm = gid * 8, gsz = (nM - fm) < 8 ? (nM - fm) : 8;
        u.pm = fm + ((wgid % nig) % gsz); u.pn = (wgid % nig) / gsz; u.e = 0; u.rows = 256; return true;
    }
    __device__ __forceinline__ unsigned arow_off(const Unit& u, int r) const { return (unsigned)(u.pm * BM + r) * (unsigned)(KD * 2); }
    __device__ __forceinline__ const unsigned char* bbase(const Unit& u) const { return Bt + (size_t)u.pn * BM * KD * 2; }
};
struct MoeOrder {
    const LAS int* tp; const int* list; const int* cnt; int npn, G, c, shift; const unsigned char* Bt; size_t bstride;
    __device__ __forceinline__ bool next(int i, Unit& u) const {
        int tl;
        if (G == 256) {
            const int x = c & 7, j = c >> 3, hn = npn >> 1, lg = npn == 8 ? 2 : 1;
            u.pn = (x & 1) * hn + (j & (hn - 1)); tl = (i * (32 >> lg) + (j >> lg)) * 4 + (x >> 1);
            if (tl >= tp[32]) return false;
        } else { const long L = (long)i * G + c; const int total = tp[32] * npn; if (L >= total) return false; tl = (int)(L / npn); u.pn = (int)(L % npn); }
        int e = 0;
#pragma unroll
        for (int j = 0; j < 32; ++j) e += (tp[j + 1] <= tl) ? 1 : 0;
        e = __builtin_amdgcn_readfirstlane(e); u.e = e; u.pm = __builtin_amdgcn_readfirstlane(tl - tp[e]); u.pn = __builtin_amdgcn_readfirstlane(u.pn);
        const int rem = cnt[e * 64] - u.pm * BM; u.rows = __builtin_amdgcn_readfirstlane(rem < BM ? rem : BM); return true;
    }
    __device__ __forceinline__ unsigned arow_off(const Unit& u, int r) const {
        const int idx = u.pm * BM + (r < u.rows ? r : 0);
        const int entry = list[(size_t)u.e * CAP + idx]; return (unsigned)(entry >> shift) * (unsigned)(KD * 2);
    }
    __device__ __forceinline__ const unsigned char* bbase(const Unit& u) const { return Bt + (size_t)u.e * bstride + (size_t)u.pn * BM * KD * 2; }
};

template <class Epi, class Sched>
__device__ __forceinline__ void gemm_phase(LAS unsigned char* lds, const unsigned char* Abase, const Sched& S, const Epi& E) {
    const int tid = otid(), wid = __builtin_amdgcn_readfirstlane(tid >> 6), lane = tid & 63, wr = wid >> 2, wc = wid & 3, fr = lane & 15, fq = lane >> 4;
    constexpr int nt = NT;
    unsigned voffB[2];
#pragma unroll
    for (int i = 0; i < 2; ++i) { int R, C; stage_rc(tid * 16 + i * 8192, R, C); const int Rb = Epi::PERM ? ((R & ~31) + perm32(R & 31)) : R; voffB[i] = (unsigned)(Rb * KD + C) * 2u; }
#define PG8_AOFF(dst, U_) do { _Pragma("unroll") for (int i_ = 0; i_ < 2; ++i_) { int R_, C_; stage_rc(otid() * 16 + i_ * 8192, R_, C_); _Pragma("unroll") for (int h_ = 0; h_ < 2; ++h_) dst[h_][i_] = S.arow_off(U_, h_ * HALF + R_) + (unsigned)C_ * 2u; } } while (0)
    const size_t kstep = (size_t)(BK * 2);
    const size_t hstep = (size_t)HALF * KD * 2;
    const unsigned ldsw = (unsigned)wid * 1024u;
    const int aoff = lds_byte(wr * 64 + fr, fq * 8), boff = lds_byte(wc * 32 + fr, fq * 8);
#define PG8_SA(b, h) (((b) * 2 + (h)) * HTB)
#define PG8_SB(b, h) ((4 + (b) * 2 + (h)) * HTB)
#define PG8_STAGE(bufoff, gbase, voff) do { _Pragma("unroll") for (int _i = 0; _i < 2; ++_i) \
        __builtin_amdgcn_global_load_lds((const unsigned*)((const unsigned char*)(gbase) + (voff)[_i]), (LAS unsigned*)(lds + (bufoff) + ldsw + _i * 8192), 16, 0, 0); } while (0)
#define PG8_LDA(dst, b, h) do { _Pragma("unroll") for (int m = 0; m < 4; ++m) _Pragma("unroll") for (int k = 0; k < 2; ++k) dst[m][k] = *(const LAS bf16x8*)(lds + PG8_SA(b, h) + aoff + m * 2048 + k * 1024); } while (0)
#define PG8_LDB(dst, b, h) do { _Pragma("unroll") for (int n = 0; n < 2; ++n) _Pragma("unroll") for (int k = 0; k < 2; ++k) dst[n][k] = *(const LAS bf16x8*)(lds + PG8_SB(b, h) + boff + n * 2048 + k * 1024); } while (0)
#define PG8_MMA(ai, bj, At, Bt) do { __builtin_amdgcn_s_setprio(1); _Pragma("unroll") for (int m = 0; m < 4; ++m) _Pragma("unroll") for (int n = 0; n < 2; ++n) _Pragma("unroll") for (int k = 0; k < 2; ++k) \
        acc[ai][bj][m][n] = __builtin_amdgcn_mfma_f32_16x16x32_bf16(Bt[n][k], At[m][k], acc[ai][bj][m][n], 0, 0, 0); __builtin_amdgcn_s_setprio(0); } while (0)
#define PG8_WAIT_V(n) asm volatile("s_waitcnt vmcnt(" #n ")" ::: "memory")
#define PG8_WAIT_L(n) asm volatile("s_waitcnt lgkmcnt(" #n ")" ::: "memory")
#define PG8_BAR __builtin_amdgcn_s_barrier()
#define PG8_SCHED __builtin_amdgcn_sched_barrier(0)
    Unit cur, nxt; int ui = 0;
    if (!S.next(0, cur)) return;
    f32x4 acc[2][2][4][2];
#pragma unroll
    for (int a = 0; a < 2; ++a)
#pragma unroll
        for (int b = 0; b < 2; ++b)
#pragma unroll
            for (int m = 0; m < 4; ++m)
#pragma unroll
                for (int n = 0; n < 2; ++n) acc[a][b][m][n] = (f32x4){0.f, 0.f, 0.f, 0.f};
    bf16x8 At[4][2], B0[2][2], B1[2][2];
    unsigned vA[2][2], nvA[2][2];
    PG8_AOFF(vA, cur);
    const unsigned char* cB = S.bbase(cur);
    PG8_STAGE(PG8_SB(0, 0), cB, voffB); PG8_STAGE(PG8_SB(0, 1), cB + hstep, voffB); PG8_STAGE(PG8_SA(0, 0), Abase, vA[0]); PG8_STAGE(PG8_SA(0, 1), Abase, vA[1]);
    if (wr == 1) PG8_BAR;
    PG8_WAIT_V(2); PG8_BAR;
    PG8_STAGE(PG8_SB(1, 0), cB + kstep, voffB); PG8_STAGE(PG8_SA(1, 0), Abase + kstep, vA[0]); PG8_STAGE(PG8_SB(1, 1), cB + hstep + kstep, voffB);
    PG8_WAIT_V(6); PG8_BAR;
    for (;;) {
        const bool has_next = S.next(ui + 1, nxt);
        const unsigned char* nB = has_next ? S.bbase(nxt) : cB;
        if (has_next) PG8_AOFF(nvA, nxt); else {
#pragma unroll
            for (int h = 0; h < 2; ++h)
#pragma unroll
                for (int i = 0; i < 2; ++i) nvA[h][i] = vA[h][i]; }
        for (int t = 0; t < nt; t += 2) {
            const bool last = (t == nt - 2);
            const unsigned char* a1 = Abase + (size_t)(t + 1) * kstep;
            const unsigned char* a2 = last ? Abase : Abase + (size_t)(t + 2) * kstep;
            const unsigned char* b2 = last ? nB : cB + (size_t)(t + 2) * kstep;
            const unsigned char* a3 = a2 + kstep; const unsigned char* b3 = b2 + kstep;
            unsigned wA0[2], wA1[2];
#pragma unroll
            for (int i = 0; i < 2; ++i) { wA0[i] = last ? nvA[0][i] : vA[0][i]; wA1[i] = last ? nvA[1][i] : vA[1][i]; }
            PG8_LDB(B0, 0, 0); PG8_LDB(B1, 0, 1); PG8_SCHED; PG8_LDA(At, 0, 0); PG8_STAGE(PG8_SA(1, 1), a1, vA[1]);
            PG8_WAIT_V(8); PG8_WAIT_L(0); PG8_BAR; PG8_MMA(0, 0, At, B0); PG8_MMA(0, 1, At, B1); PG8_BAR; PG8_SCHED;
            PG8_LDA(At, 0, 1); PG8_STAGE(PG8_SB(0, 0), b2, voffB); PG8_STAGE(PG8_SB(0, 1), b2 + hstep, voffB); PG8_STAGE(PG8_SA(0, 0), a2, wA0);
            PG8_WAIT_V(8); PG8_WAIT_L(0); PG8_BAR; PG8_MMA(1, 0, At, B0); PG8_MMA(1, 1, At, B1); PG8_BAR; PG8_SCHED;
            PG8_LDB(B0, 1, 0); PG8_LDB(B1, 1, 1); PG8_SCHED; PG8_LDA(At, 1, 0); PG8_STAGE(PG8_SA(0, 1), a2, wA1);
            PG8_WAIT_V(8); PG8_WAIT_L(0); PG8_BAR; PG8_MMA(0, 0, At, B0); PG8_MMA(0, 1, At, B1); PG8_BAR; PG8_SCHED;
            PG8_LDA(At, 1, 1); PG8_STAGE(PG8_SB(1, 0), b3, voffB); PG8_STAGE(PG8_SB(1, 1), b3 + hstep, voffB); PG8_STAGE(PG8_SA(1, 0), a3, wA0);
            PG8_WAIT_V(8); PG8_WAIT_L(0); PG8_BAR; PG8_MMA(1, 0, At, B0); PG8_MMA(1, 1, At, B1); PG8_BAR; PG8_SCHED;
        }
        if (wr == 0) PG8_BAR;
        E(acc, cur, wr, wc, fr, fq);
        if (!has_next) break;
#pragma unroll
        for (int a = 0; a < 2; ++a)
#pragma unroll
            for (int b = 0; b < 2; ++b)
#pragma unroll
                for (int m = 0; m < 4; ++m)
#pragma unroll
                    for (int n = 0; n < 2; ++n) acc[a][b][m][n] = (f32x4){0.f, 0.f, 0.f, 0.f};
        cur = nxt; cB = nB; ++ui;
#pragma unroll
        for (int h = 0; h < 2; ++h)
#pragma unroll
            for (int i = 0; i < 2; ++i) vA[h][i] = nvA[h][i];
        if (wr == 1) PG8_BAR;
    }
    PG8_WAIT_V(0);
    PG8_BAR;
#undef PG8_AOFF
#undef PG8_SA
#undef PG8_SB
#undef PG8_STAGE
#undef PG8_LDA
#undef PG8_LDB
#undef PG8_MMA
#undef PG8_WAIT_V
#undef PG8_WAIT_L
#undef PG8_BAR
#undef PG8_SCHED
}
}

namespace pg8 {
struct EpiInProj {
    static constexpr bool PERM = true;
    bf16_t* O;
    __device__ __forceinline__ void operator()(const f32x4 (&acc)[2][2][4][2], const Unit& u, int wr, int wc, int fr, int fq) const {
        const int row0 = u.pm * BM + wr * 64 + fr, col0 = u.pn * BM + wc * 32 + 8 * fq;
#pragma unroll
        for (int ai = 0; ai < 2; ++ai)
#pragma unroll
            for (int m = 0; m < 4; ++m) { bf16_t* rowp = O + (size_t)(row0 + ai * HALF + m * 16) * INP + col0;
#pragma unroll
                for (int bj = 0; bj < 2; ++bj) { const f32x4 v0 = acc[ai][bj][m][0], v1 = acc[ai][bj][m][1];
                    u32x4 w; w.x = pk2(v0[0], v0[1]); w.y = pk2(v0[2], v0[3]); w.z = pk2(v1[0], v1[1]); w.w = pk2(v1[2], v1[3]);
                    *(u32x4*)(rowp + bj * HALF) = w; } }
    }
};
struct EpiOutProj {
    static constexpr bool PERM = false;
    const float* xlat; const float* xctx; float* xbuf; const float* mod;
    __device__ __forceinline__ void operator()(const f32x4 (&acc)[2][2][4][2], const Unit& u, int wr, int wc, int fr, int fq) const {
        const int rowt = u.pm * BM; const int mrow = rowt < NLAT ? (rowt >> 13) : 4;
        const float* gate = mod + mrow * 6144 + 2 * 1024;
        const float* src = rowt < NLAT ? xlat + (size_t)rowt * D : xctx + (size_t)(rowt - NLAT) * D;
        float* dst = xbuf + (size_t)rowt * D;
#pragma unroll
        for (int ai = 0; ai < 2; ++ai)
#pragma unroll
            for (int m = 0; m < 4; ++m) { const int r = ai * HALF + wr * 64 + m * 16 + fr;
#pragma unroll
                for (int bj = 0; bj < 2; ++bj)
#pragma unroll
                    for (int n = 0; n < 2; ++n) { const int c = u.pn * BM + bj * HALF + wc * 32 + n * 16 + 4 * fq;
                        const f32x4 g = *(const f32x4*)(gate + c); const f32x4 xv = *(const f32x4*)(src + (size_t)r * D + c);
                        *(f32x4*)(dst + (size_t)r * D + c) = xv + g * acc[ai][bj][m][n]; } }
    }
};
__device__ __forceinline__ float swiglu(float g, float l) { g = fminf(g, 7.f); l = fminf(fmaxf(l, -7.f), 7.f); return g * sigm(1.702f * g) * (l + 1.f); }
__device__ __forceinline__ unsigned swiglu_pk(float g0, float l0, float g1, float l1) {
    g0 = fminf(g0, 7.f); g1 = fminf(g1, 7.f); l0 = fminf(fmaxf(l0, -7.f), 7.f); l1 = fminf(fmaxf(l1, -7.f), 7.f);
    const float d0 = 1.f + __builtin_amdgcn_exp2f(-2.4554669595930156f * g0), d1 = 1.f + __builtin_amdgcn_exp2f(-2.4554669595930156f * g1);
    const float r = __builtin_amdgcn_rcpf(d0 * d1);
    return pk2(g0 * (r * d1) * (l0 + 1.f), g1 * (r * d0) * (l1 + 1.f));
}
struct EpiMoe1 {
    static constexpr bool PERM = true;
    const int* list; const float* b1; bf16_t* H;
    __device__ __forceinline__ void operator()(const f32x4 (&acc)[2][2][4][2], const Unit& u, int wr, int wc, int fr, int fq) const {
        const int hc = u.pn * 128 + wc * 32 + 8 * fq;
        const float* bg = b1 + (size_t)u.e * 2048 + hc; const float* bl = bg + 1024;
        const f32x4 bg0 = *(const f32x4*)bg, bg1 = *(const f32x4*)(bg + 4), bl0 = *(const f32x4*)bl, bl1 = *(const f32x4*)(bl + 4);
#pragma unroll
        for (int ai = 0; ai < 2; ++ai)
#pragma unroll
            for (int m = 0; m < 4; ++m) { const int r = ai * HALF + wr * 64 + m * 16 + fr;
                if (r < u.rows) { const int entry = list[(size_t)u.e * CAP + u.pm * BM + r];
                    const f32x4 g0 = acc[ai][0][m][0] + bg0, g1 = acc[ai][0][m][1] + bg1, l0 = acc[ai][1][m][0] + bl0, l1 = acc[ai][1][m][1] + bl1;
                    u32x4 w; w.x = swiglu_pk(g0[0], l0[0], g0[1], l0[1]); w.y = swiglu_pk(g0[2], l0[2], g0[3], l0[3]);
                    w.z = swiglu_pk(g1[0], l1[0], g1[1], l1[1]); w.w = swiglu_pk(g1[2], l1[2], g1[3], l1[3]);
                    *(u32x4*)(H + (size_t)entry * 1024 + hc) = w; } }
    }
};
struct EpiMoe2 {
    static constexpr bool PERM = true;
    const int* list; const float* b2; const float* gate; bf16_t* YK;
    __device__ __forceinline__ void operator()(const f32x4 (&acc)[2][2][4][2], const Unit& u, int wr, int wc, int fr, int fq) const {
        const int c0 = u.pn * BM + wc * 32 + 8 * fq;
        const float* bb = b2 + (size_t)u.e * 1024 + c0;
        f32x4 bv[2][2];
#pragma unroll
        for (int bj = 0; bj < 2; ++bj) { bv[bj][0] = *(const f32x4*)(bb + bj * HALF); bv[bj][1] = *(const f32x4*)(bb + bj * HALF + 4); }
#pragma unroll
        for (int ai = 0; ai < 2; ++ai)
#pragma unroll
            for (int m = 0; m < 4; ++m) { const int r = ai * HALF + wr * 64 + m * 16 + fr;
                if (r < u.rows) { const int entry = list[(size_t)u.e * CAP + u.pm * BM + r]; const float g = gate[entry];
#pragma unroll
                    for (int bj = 0; bj < 2; ++bj) { const f32x4 v0 = (acc[ai][bj][m][0] + bv[bj][0]) * g, v1 = (acc[ai][bj][m][1] + bv[bj][1]) * g;
                        u32x4 w; w.x = pk2(v0[0], v0[1]); w.y = pk2(v0[2], v0[3]); w.z = pk2(v1[0], v1[1]); w.w = pk2(v1[2], v1[3]);
                        *(u32x4*)(YK + (size_t)entry * 1024 + c0 + bj * HALF) = w; } } }
    }
};
}

#define WSP(T_, off) ((T_*)(p->ws + (off)))
#define RWA(i) WSP(float, WS_RWA + (size_t)(i) * RWA_STRIDE)
#define RWB(i) WSP(bf16_t, WS_RWA + (size_t)(i) * RWA_STRIDE)

struct WCItem { const float* W; bf16_t* WT; int ldw, n0, nvalid, k0, drow0; };
constexpr int WC_N0 = 1408, WC_N1 = 1408 + 512 + 32768 + 16384, WC_N2 = 512 + 32768 + 16384;
__device__ __forceinline__ WCItem wc_decode(KPP p, int set, int it) {
    WCItem c; int r = it, l = set == 2 ? 1 : 0;
    if (set <= 1 && (set == 0 || r < 1408)) { const int lw = set, kb = r / 88, nb = r % 88; c.WT = WSP(bf16_t, WS_WIN) + (size_t)lw * INP * 1024; c.k0 = kb * 64;
        if (nb < 87) { c.W = p->in[I_WIN] + (size_t)lw * 1024 * INW; c.ldw = INW; c.n0 = nb * 32; c.nvalid = INW; c.drow0 = nb * 32; }
        else { c.W = p->in[I_RVDOWN]; c.ldw = 32; c.n0 = 0; c.nvalid = lw == 1 ? 32 : 0; c.drow0 = UC_HV; }
        return c; }
    if (set == 1) r -= 1408;
    if (r < 512) { const int kb = r / 32, nb = r % 32; c.W = p->in[I_WOUT] + (size_t)l * 1024 * 1024; c.ldw = 1024; c.n0 = nb * 32; c.nvalid = 1024; c.k0 = kb * 64; c.WT = WSP(bf16_t, WS_WOUT) + (size_t)l * 1024 * 1024; c.drow0 = nb * 32; return c; }
    r -= 512;
    if (r < 32768) { const int le = l * 32 + r / 1024, q = r % 1024, kb = q / 64, nb = q % 64, n0 = nb * 32;
        c.W = p->in[I_W1] + (size_t)le * 1024 * 2048; c.ldw = 2048; c.n0 = n0; c.nvalid = 2048; c.k0 = kb * 64; c.WT = WSP(bf16_t, WS_W1) + (size_t)le * 2048 * 1024;
        c.drow0 = n0 < 1024 ? 256 * (n0 / 128) + (n0 % 128) : 256 * ((n0 - 1024) / 128) + 128 + ((n0 - 1024) % 128); return c; }
    r -= 32768;
    { const int le = l * 32 + r / 512, q = r % 512, kb = q / 32, nb = q % 32;
        c.W = p->in[I_W2] + (size_t)le * 1024 * 1024; c.ldw = 1024; c.n0 = nb * 32; c.nvalid = 1024; c.k0 = kb * 64; c.WT = WSP(bf16_t, WS_W2) + (size_t)le * 1024 * 1024; c.drow0 = nb * 32; return c; }
}
__device__ __forceinline__ void wc_issue(const WCItem& c, int lane, f32x4 (&v)[8]) {
    const int kk = lane >> 3, nq = (lane & 7) * 4; const bool ok = c.n0 + nq < c.nvalid;
#pragma unroll
    for (int i = 0; i < 8; ++i) v[i] = ok ? __builtin_nontemporal_load((const f32x4*)(c.W + (size_t)(c.k0 + kk + 8 * i) * c.ldw + c.n0 + nq)) : (f32x4){0.f, 0.f, 0.f, 0.f};
}
__device__ __forceinline__ void wc_finish(const WCItem& c, int lane, LAS float* scr, const f32x4 (&v)[8]) {
    const int kk = lane >> 3, nq = (lane & 7) * 4;
#pragma unroll
    for (int i = 0; i < 8; ++i) { LAS float* d = scr + (kk + 8 * i) * 33 + nq; d[0] = v[i][0]; d[1] = v[i][1]; d[2] = v[i][2]; d[3] = v[i][3]; }
    LDS_FENCE();
    const int cc = lane & 7;
#pragma unroll
    for (int j = 0; j < 4; ++j) { const int nn = (lane >> 3) + 8 * j; const LAS float* s = scr + (8 * cc) * 33 + nn;
        u32x4 o; o.x = pk2(s[0], s[33]); o.y = pk2(s[66], s[99]); o.z = pk2(s[132], s[165]); o.w = pk2(s[198], s[231]);
        *(u32x4*)(c.WT + (size_t)(c.drow0 + nn) * 1024 + c.k0 + 8 * cc) = o; }
    LDS_FENCE();
}
__device__ __forceinline__ void weight_copy_item(KPP p, int set, int it, LAS float* scr, int lane) {
    const WCItem c = wc_decode(p, set, it); f32x4 v[8]; wc_issue(c, lane, v); wc_finish(c, lane, scr, v);
}
__device__ __forceinline__ void weight_copy_run(KPP p, int set, int b0, int b1, LAS float* scr, int lane) {
    WCItem c0 = wc_decode(p, set, b0), c1 = c0; f32x4 v0[8], v1[8]; wc_issue(c0, lane, v0);
    for (int it = b0; it < b1; it += 2) {
        if (it + 1 < b1) { c1 = wc_decode(p, set, it + 1); wc_issue(c1, lane, v1); }
        wc_finish(c0, lane, scr, v0);
        if (it + 1 < b1) { if (it + 2 < b1) { c0 = wc_decode(p, set, it + 2); wc_issue(c0, lane, v0); } wc_finish(c1, lane, scr, v1); }
    }
}
__device__ __forceinline__ void phase_p0a(KPP p, LAS unsigned char* lds) {
    const int tid = otid(), lane = tid & 63, wave = tid >> 6;
    const int gw = obid() * NWAVES + wave, ngw = gridDim.x * NWAVES;
    float* MOD = WSP(float, WS_MOD);
    for (int it = obid(); it < 192; it += gridDim.x) {
        const int l = it / 96, cb = it % 96, n = cb * 64 + lane;
        const float* W = p->in[I_ADAW] + (size_t)l * 1024 * 6144;
        float acc[5] = {0.f, 0.f, 0.f, 0.f, 0.f};
        for (int k8 = wave * 128; k8 < wave * 128 + 128; k8 += 8) {
            float w[8];
#pragma unroll
            for (int q = 0; q < 8; ++q) w[q] = W[(size_t)(k8 + q) * 6144 + n];
#pragma unroll
            for (int q = 0; q < 8; ++q) { const int k = k8 + q;
#pragma unroll
                for (int r = 0; r < 5; ++r) { const float cv = r < 4 ? p->in[I_C][r * 1024 + k] : p->in[I_CCTX][k]; acc[r] += (cv * sigm(cv)) * w[q]; } }
        }
        LAS float* red = (LAS float*)lds;
#pragma unroll
        for (int r = 0; r < 5; ++r) red[(wave * 5 + r) * 64 + lane] = acc[r];
        __syncthreads();
        if (wave < 5) { float s = 0.f;
#pragma unroll
            for (int w = 0; w < 8; ++w) s += red[(w * 5 + wave) * 64 + lane];
            MOD[(size_t)(l * 5 + wave) * 6144 + n] = s + p->in[I_ADAB][l * 6144 + n]; }
        __syncthreads();
    }
    { const int gt = obid() * NTHR + tid; if (gt < 2048) { const int pos = gt >> 4, f = gt & 15;
        const float inv = powf(10000.f, -(float)f / 16.f); const float ang = (float)pos * inv; float* RT = WSP(float, WS_ROPE); RT[gt * 2] = cosf(ang); RT[gt * 2 + 1] = sinf(ang); } }
    LAS float* scr = (LAS float*)(lds + 16384) + wave * (64 * 33);
    for (int it = gw; it < 1408; it += ngw) weight_copy_item(p, 0, it, scr, lane);
}

__device__ __forceinline__ void norm_mod_store(const f32x4 (&v)[4], const float* g, const float* shift, const float* scale, bf16_t* orow, int lane) {
    float ss = 0.f;
#pragma unroll
    for (int j = 0; j < 4; ++j) ss += (v[j][0] * v[j][0] + v[j][1] * v[j][1]) + (v[j][2] * v[j][2] + v[j][3] * v[j][3]);
    const float rstd = rsqrtf(wsum(ss) * (1.f / 1024.f) + 1e-6f);
#pragma unroll
    for (int j = 0; j < 4; ++j) { const int k = 4 * (lane + 64 * j);
        const f32x4 gg = *(const f32x4*)(g + k), sh = *(const f32x4*)(shift + k), sc = *(const f32x4*)(scale + k);
        const f32x4 o = (v[j] * rstd * gg) * (sc + 1.f) + sh;
        u32x2 w; w.x = pk2(o[0], o[1]); w.y = pk2(o[2], o[3]); *(u32x2*)(orow + k) = w; }
}
__device__ __forceinline__ void phase_norm1(KPP p, int l, const float* xlat, const float* xctx) {
    const int lane = otid() & 63, wave = otid() >> 6, gw = obid() * NWAVES + wave, ngw = gridDim.x * NWAVES;
    const float* g = p->in[I_N1G] + l * 1024; const float* MOD = WSP(float, WS_MOD) + (size_t)l * 5 * 6144; bf16_t* H = WSP(bf16_t, WS_H);
    f32x4 nv[4];
#define N1_FETCH(m_) do { const float* xr_ = (m_) < NLAT ? xlat + (size_t)(m_) * D : xctx + (size_t)((m_) - NLAT) * D; _Pragma("unroll") for (int j = 0; j < 4; ++j) nv[j] = *(const f32x4*)(xr_ + 4 * (lane + 64 * j)); } while (0)
    if (gw < NTOK) N1_FETCH(gw);
    for (int m = gw; m < NTOK; m += ngw) {
        const int mr = m < NLAT ? (m >> 13) : 4;
        f32x4 v[4];
#pragma unroll
        for (int j = 0; j < 4; ++j) v[j] = nv[j];
        if (m + ngw < NTOK) N1_FETCH(m + ngw);
        norm_mod_store(v, g, MOD + mr * 6144, MOD + mr * 6144 + 1024, H + (size_t)m * D, lane);
    }
#undef N1_FETCH
}

__device__ __forceinline__ void seq_info(int m, int& pos, int& len) { if (m < NLAT) { pos = m & (T - 1); len = T; } else { pos = (m - NLAT) & (LC - 1); len = LC; } }
__device__ __forceinline__ f32x4 ld4bf(const bf16_t* ptr) { const u32x2 w = *(const u32x2*)ptr; return (f32x4){bflo(w.x), bfhi(w.x), bflo(w.y), bfhi(w.y)}; }
__device__ __forceinline__ void st4bf(bf16_t* ptr, f32x4 v) { u32x2 w; w.x = pk2(v[0], v[1]); w.y = pk2(v[2], v[3]); *(u32x2*)ptr = w; }

__device__ __forceinline__ void phase_prep(KPP p, int l, LAS unsigned char* lds) {
    const int tid = otid(), lane = tid & 63, wave = tid >> 6;
    const int gw = obid() * NWAVES + wave, ngw = gridDim.x * NWAVES;
    const int gt = obid() * NTHR + tid, ngt = gridDim.x * NTHR;
    const bf16_t* U = WSP(bf16_t, WS_U);
    { const float* RT = WSP(float, WS_ROPE); bf16_t* QR = WSP(bf16_t, WS_QR); bf16_t* KR = WSP(bf16_t, WS_KR);
      u32x4 nw[4];
#define RP_FETCH(idx_) do { const int m_ = (idx_) / 20, r_ = (idx_) % 20, hh_ = r_ >> 1, a_ = r_ & 1; const bf16_t* src_ = U + (size_t)m_ * INP + (hh_ < 8 ? hh_ * 64 : 512 + (hh_ - 8) * 64) + a_ * 32; \
        _Pragma("unroll") for (int q = 0; q < 4; ++q) nw[q] = ((const u32x4*)src_)[q]; } while (0)
      if (gt < NTOK * 20) RP_FETCH(gt);
      for (int idx = gt; idx < NTOK * 20; idx += ngt) {
        const int m = idx / 20, r = idx % 20, hh = r >> 1, a = r & 1;
        u32x4 w[4];
#pragma unroll
        for (int q = 0; q < 4; ++q) w[q] = nw[q];
        if (idx + ngt < NTOK * 20) RP_FETCH(idx + ngt);
        float x1[16], x2[16];
#pragma unroll
        for (int q = 0; q < 2; ++q) { x1[8 * q] = bflo(w[q].x); x1[8 * q + 1] = bfhi(w[q].x); x1[8 * q + 2] = bflo(w[q].y); x1[8 * q + 3] = bfhi(w[q].y); x1[8 * q + 4] = bflo(w[q].z); x1[8 * q + 5] = bfhi(w[q].z); x1[8 * q + 6] = bflo(w[q].w); x1[8 * q + 7] = bfhi(w[q].w);
            x2[8 * q] = bflo(w[q + 2].x); x2[8 * q + 1] = bfhi(w[q + 2].x); x2[8 * q + 2] = bflo(w[q + 2].y); x2[8 * q + 3] = bfhi(w[q + 2].y); x2[8 * q + 4] = bflo(w[q + 2].z); x2[8 * q + 5] = bfhi(w[q + 2].z); x2[8 * q + 6] = bflo(w[q + 2].w); x2[8 * q + 7] = bfhi(w[q + 2].w); }
        const float sc = hh < 8 ? QSCALE : 1.f;
        if (m < NLAT) { const int t = m & (T - 1); const int pos = a == 0 ? (t >> 6) : (t & 63); const f32x2* cs = (const f32x2*)(RT + pos * 32);
#pragma unroll
            for (int f = 0; f < 16; ++f) { const f32x2 c = cs[f]; const float o1 = x1[f] * c[0] - x2[f] * c[1], o2 = x2[f] * c[0] + x1[f] * c[1]; x1[f] = o1 * sc; x2[f] = o2 * sc; } }
        else {
#pragma unroll
            for (int f = 0; f < 16; ++f) { x1[f] *= sc; x2[f] *= sc; } }
        bf16_t* dst = hh < 8 ? QR + (size_t)m * 512 + hh * 64 + a * 32 : KR + (size_t)m * 128 + (hh - 8) * 64 + a * 32;
#pragma unroll
        for (int q = 0; q < 2; ++q) { u32x4 o; o.x = pk2(x1[8 * q], x1[8 * q + 1]); o.y = pk2(x1[8 * q + 2], x1[8 * q + 3]); o.z = pk2(x1[8 * q + 4], x1[8 * q + 5]); o.w = pk2(x1[8 * q + 6], x1[8 * q + 7]); ((u32x4*)dst)[q] = o;
            u32x4 o2; o2.x = pk2(x2[8 * q], x2[8 * q + 1]); o2.y = pk2(x2[8 * q + 2], x2[8 * q + 3]); o2.z = pk2(x2[8 * q + 4], x2[8 * q + 5]); o2.w = pk2(x2[8 * q + 6], x2[8 * q + 7]); ((u32x4*)dst)[q + 2] = o2; }
      } }
    { const float* cwm = p->in[I_MCONV] + (size_t)l * 3 * 512; bf16_t* MQB = WSP(bf16_t, WS_MQB); bf16_t* MKB = WSP(bf16_t, WS_MKB);
      u32x2 r0, r1, r2;
#define MF_FETCH(idx_) do { const int m_ = (idx_) >> 7, c_ = ((idx_) & 127) * 4; int pos_, len_; seq_info(m_, pos_, len_); const bf16_t* up_ = U + (size_t)m_ * INP + UC_ML + c_; \
        r1 = *(const u32x2*)up_; r0 = pos_ > 0 ? *(const u32x2*)(up_ - INP) : (u32x2){0u, 0u}; r2 = pos_ < len_ - 1 ? *(const u32x2*)(up_ + INP) : (u32x2){0u, 0u}; } while (0)
      if (gt < NTOK * 128) MF_FETCH(gt);
      for (int idx = gt; idx < NTOK * 128; idx += ngt) {
        const int m = idx >> 7, c4 = (idx & 127) * 4;
        const f32x4 x0 = (f32x4){bflo(r0.x), bfhi(r0.x), bflo(r0.y), bfhi(r0.y)}, x1 = (f32x4){bflo(r1.x), bfhi(r1.x), bflo(r1.y), bfhi(r1.y)}, x2 = (f32x4){bflo(r2.x), bfhi(r2.x), bflo(r2.y), bfhi(r2.y)};
        if (idx + ngt < NTOK * 128) MF_FETCH(idx + ngt);
        const f32x4 w0 = *(const f32x4*)(cwm + c4), w1 = *(const f32x4*)(cwm + 512 + c4), w2 = *(const f32x4*)(cwm + 1024 + c4);
        f32x4 y = x0 * w0 + x1 * w1 + x2 * w2;
#pragma unroll
        for (int i = 0; i < 4; ++i) y[i] = y[i] * sigm(y[i]);
        if (c4 < 256) st4bf(MQB + (size_t)m * 256 + c4, y); else st4bf(MKB + (size_t)m * 256 + c4 - 256, y * 0.125f);
      }
#undef MF_FETCH
    }
    {
      __syncthreads();
      { const int rot = (obid() * 7) % 224;
        for (int f = tid; f < 224 * 64; f += NTHR) { int row = (f >> 6) + rot; row = row >= 224 ? row - 224 : row; const int q = f & 63;
          const float* src = row < 64 ? p->in[I_RWUP] + (size_t)l * 64 * 256 + (size_t)row * 256 : row < 128 ? p->in[I_RAUP] + (size_t)l * 64 * 256 + (size_t)(row - 64) * 256 : row < 192 ? p->in[I_RGUP] + (size_t)l * 64 * 256 + (size_t)(row - 128) * 256 : p->in[I_RVUP] + (size_t)(row - 192) * 256;
          if (row < 192 || l == 1) { const f32x4 v = *(const f32x4*)(src + q * 4); u32x2 w; w.x = pk2(v[0], v[1]); w.y = pk2(v[2], v[3]); *(LAS u32x2*)(lds + row * 512 + q * 8) = w; } } }
      __syncthreads();
      LAS float* sx = (LAS float*)(lds + 114688) + wave * (4 * 224);
#define LORA_ROW(r_) ({ const u32x2 w_ = *(const LAS u32x2*)(lds + (r_) * 512 + c4 * 2); (f32x4){bflo(w_.x), bfhi(w_.x), bflo(w_.y), bfhi(w_.y)}; })
      const float* cw = p->in[I_RCONV] + (size_t)l * 3 * 960;
      const float* w0p = p->in[I_RW0] + l * 512; const float* wup = p->in[I_RWUP] + (size_t)l * 2 * 32 * 256;
      const float* a0p = p->in[I_RA0] + l * 512; const float* aup = p->in[I_RAUP] + (size_t)l * 2 * 32 * 256;
      const float* gup = p->in[I_RGUP] + (size_t)l * 64 * 256;
      const float* kkw = p->in[I_RKK] + l * 256; const float* kaw = p->in[I_RKA] + l * 256;
      const float* v0p = p->in[I_RV0]; const float* vup = p->in[I_RVUP];
      float* VF = WSP(float, WS_VF);
      const int c4 = lane * 4;
      u32x2 nraw[6][3]; bf16_t nxs[3][6];
#define RW_FETCH(grp_) do { const int m0_ = (grp_) * 4; int pos0_, len_; seq_info(m0_, pos0_, len_); const bool hp_ = pos0_ > 0, hn_ = pos0_ + 4 < len_; \
        _Pragma("unroll") for (int j = 0; j < 6; ++j) { const bool ok_ = (j == 0) ? hp_ : ((j == 5) ? hn_ : true); const bf16_t* rp_ = U + (size_t)(m0_ - 1 + j) * INP + UC_RW; \
            _Pragma("unroll") for (int g = 0; g < 3; ++g) { nraw[j][g] = ok_ ? *(const u32x2*)(rp_ + g * 256 + c4) : (u32x2){0u, 0u}; nxs[g][j] = ok_ ? rp_[768 + 64 * g + lane] : (bf16_t)0; } } } while (0)
      if (gw < NTOK / 4) RW_FETCH(gw);
      for (int grp = gw; grp < NTOK / 4; grp += ngw) {
        const int m0 = grp * 4;
        f32x4 cv[4][3];
        { f32x4 raw[6][3];
#pragma unroll
          for (int j = 0; j < 6; ++j)
#pragma unroll
            for (int g = 0; g < 3; ++g) raw[j][g] = (f32x4){bflo(nraw[j][g].x), bfhi(nraw[j][g].x), bflo(nraw[j][g].y), bfhi(nraw[j][g].y)};
#pragma unroll
          for (int g = 0; g < 3; ++g) { const f32x4 k0 = *(const f32x4*)(cw + g * 256 + c4), k1 = *(const f32x4*)(cw + 960 + g * 256 + c4), k2 = *(const f32x4*)(cw + 1920 + g * 256 + c4);
#pragma unroll
            for (int tk = 0; tk < 4; ++tk) cv[tk][g] = raw[tk][g] * k0 + raw[tk + 1][g] * k1 + raw[tk + 2][g] * k2; } }
#pragma unroll
        for (int g = 0; g < 3; ++g) { const int col = 768 + 64 * g + lane; float x[6];
#pragma unroll
          for (int j = 0; j < 6; ++j) x[j] = bf2f(nxs[g][j]);
          const float k0 = cw[col], k1 = cw[960 + col], k2 = cw[1920 + col];
#pragma unroll
          for (int tk = 0; tk < 4; ++tk) { float val = x[tk] * k0 + x[tk + 1] * k1 + x[tk + 2] * k2; if (g == 0) val = 1.f - 2.f * __builtin_amdgcn_rcpf(1.f + __expf(2.f * val)); if (g == 2) val = sigm(val); sx[tk * 224 + g * 64 + lane] = val; } }
        if (grp + ngw < NTOK / 4) RW_FETCH(grp + ngw);
        if (l == 1 && lane < 32) {
#pragma unroll
          for (int tk = 0; tk < 4; ++tk) sx[tk * 224 + 192 + lane] = bf2f(U[(size_t)(m0 + tk) * INP + UC_HV + lane]); }
        LDS_FENCE();
        const f32x4 kk_w = *(const f32x4*)(kkw + c4), ka_w = *(const f32x4*)(kaw + c4);
        f32x4 kkv[4];
#pragma unroll
        for (int tk = 0; tk < 4; ++tk) { const size_t o = (size_t)(m0 + tk) * 256 + c4;
          st4bf(RWB(RA_R) + o, cv[tk][0]);
          const f32x4 kkr = cv[tk][1] * kk_w; float ss = (kkr[0] * kkr[0] + kkr[1] * kkr[1]) + (kkr[2] * kkr[2] + kkr[3] * kkr[3]); ss = gsum16(ss);
          const float inv = 1.f / fmaxf(sqrtf(ss), 1e-12f);
          kkv[tk] = kkr * inv; st4bf(RWB(RA_KK) + o, kkv[tk]); }
        for (int d = 0; d < 2; ++d) {
          f32x4 acc[4];
#pragma unroll
          for (int tk = 0; tk < 4; ++tk) acc[tk] = *(const f32x4*)(w0p + d * 256 + c4);
#pragma unroll 4
          for (int j = 0; j < 32; ++j) { const f32x4 wr_ = LORA_ROW(d * 32 + j);
#pragma unroll
            for (int tk = 0; tk < 4; ++tk) acc[tk] += wr_ * sx[tk * 224 + d * 32 + j]; }
#pragma unroll
          for (int tk = 0; tk < 4; ++tk) { f32x4 lw;
#pragma unroll
            for (int i = 0; i < 4; ++i) lw[i] = -0.6065306597126334f * sigm(acc[tk][i]);
            *(f32x4*)(RWA(RA_LW0 + d) + (size_t)(m0 + tk) * 256 + c4) = lw; }
#pragma unroll
          for (int tk = 0; tk < 4; ++tk) acc[tk] = *(const f32x4*)(a0p + d * 256 + c4);
#pragma unroll 4
          for (int j = 0; j < 32; ++j) { const f32x4 ar_ = LORA_ROW(64 + d * 32 + j);
#pragma unroll
            for (int tk = 0; tk < 4; ++tk) acc[tk] += ar_ * sx[tk * 224 + 64 + d * 32 + j]; }
#pragma unroll
          for (int tk = 0; tk < 4; ++tk) { f32x4 a, kd;
#pragma unroll
            for (int i = 0; i < 4; ++i) { a[i] = sigm(acc[tk][i]); kd[i] = cv[tk][1][i] * (1.f + (a[i] - 1.f) * ka_w[i]); }
            st4bf(RWB(RA_A0 + d) + (size_t)(m0 + tk) * 256 + c4, a * kkv[tk]); st4bf(RWB(RA_KD0 + d) + (size_t)(m0 + tk) * 256 + c4, kd); }
        }
        { f32x4 acc[4];
#pragma unroll
          for (int tk = 0; tk < 4; ++tk) acc[tk] = (f32x4){0.f, 0.f, 0.f, 0.f};
#pragma unroll 4
          for (int j = 0; j < 64; ++j) { const f32x4 gr_ = LORA_ROW(128 + j);
#pragma unroll
            for (int tk = 0; tk < 4; ++tk) acc[tk] += gr_ * sx[tk * 224 + 128 + j]; }
#pragma unroll
          for (int tk = 0; tk < 4; ++tk) st4bf(RWB(RA_G) + (size_t)(m0 + tk) * 256 + c4, acc[tk]); }
        if (l == 0) {
#pragma unroll
          for (int tk = 0; tk < 4; ++tk) { const size_t o = (size_t)(m0 + tk) * 256 + c4; *(f32x4*)(VF + o) = cv[tk][2]; st4bf(RWB(RA_V) + o, cv[tk][2]); }
        } else { f32x4 acc[4];
#pragma unroll
          for (int tk = 0; tk < 4; ++tk) acc[tk] = *(const f32x4*)(v0p + c4);
#pragma unroll 4
          for (int j = 0; j < 32; ++j) { const f32x4 vr_ = LORA_ROW(192 + j);
#pragma unroll
            for (int tk = 0; tk < 4; ++tk) acc[tk] += vr_ * sx[tk * 224 + 192 + j]; }
#pragma unroll
          for (int tk = 0; tk < 4; ++tk) { const size_t o = (size_t)(m0 + tk) * 256 + c4; const f32x4 vf = *(const f32x4*)(VF + o); f32x4 v = cv[tk][2];
#pragma unroll
            for (int i = 0; i < 4; ++i) v[i] = v[i] + (vf[i] - v[i]) * sigm(acc[tk][i]);
            st4bf(RWB(RA_V) + o, v); } }
        LDS_FENCE();
      } }
}

template <int CTRL> __device__ __forceinline__ float dppf(float x) { return __int_as_float(__builtin_amdgcn_update_dpp(0, __float_as_int(x), CTRL, 0xF, 0xF, true)); }
__device__ __forceinline__ float red8(float x) { x += dppf<0xB1>(x); x += dppf<0x4E>(x); x += dppf<0x141>(x); return x; }
__device__ __forceinline__ int scan_row(int b, int d, int tau) {
    if (tau < LC) return NLAT + b * LC + (d ? LC - 1 - tau : tau);
    const int t = tau - LC; return b * T + (d ? T - 1 - t : t);
}
__device__ __forceinline__ int crow16(int r, int hi) { return (r & 3) + 8 * (r >> 2) + 4 * hi; }
constexpr int TP = 144, TSZ = 64 * TP;
constexpr int NCH = (LC + T) / 64;
constexpr int ML_T0 = 0, ML_T1 = TSZ, ML_T2 = 2 * TSZ, ML_T3 = 3 * TSZ, ML_T4 = 4 * TSZ, ML_AR = 5 * TSZ;
__device__ __forceinline__ f32x16 mm32(const LAS unsigned char* A, const LAS unsigned char* Bt, int r0, int c0, int r32, int hi, f32x16 acc) {
#pragma unroll
    for (int ks = 0; ks < 4; ++ks) { const bf16x8 a = *(const LAS bf16x8*)(A + (r0 + r32) * TP + ks * 32 + hi * 16), b = *(const LAS bf16x8*)(Bt + (c0 + r32) * TP + ks * 32 + hi * 16);
        acc = __builtin_amdgcn_mfma_f32_32x32x16_bf16(a, b, acc, 0, 0, 0); }
    return acc;
}
__device__ __forceinline__ f32x16 zero16() { f32x16 z;
#pragma unroll
    for (int r = 0; r < 16; ++r) z[r] = 0.f;
    return z; }
__device__ __forceinline__ float logsig(float v) { const float e = __expf(-fabsf(v)); return fminf(v, 0.f) - __logf(1.f + e); }
__device__ __forceinline__ void mlstm_phaseA(KPP p, int l, LAS unsigned char* lds) {
    const int tid = otid(), lane = tid & 63, wave = __builtin_amdgcn_readfirstlane(tid >> 6), half = wave >> 2, hw = wave & 3, htid = tid & 255, r32 = lane & 31, hi = lane >> 5;
    const bf16_t* U = WSP(bf16_t, WS_U); const bf16_t* MKB = WSP(bf16_t, WS_MKB); float* GT = WSP(float, WS_GT);
    float* DC = WSP(float, WS_MLDC); float* DN = WSP(float, WS_MLSM); float* GX = DN + 2 * 4224 * 64;
    const float* gb = p->in[I_MGB] + l * 16;
    LAS unsigned char* hb = lds + half * 24576; LAS float* sWK = (LAS float*)(hb + 2 * TSZ); LAS float* red = sWK + 64;
    const int G = gridDim.x;
#define MA_FETCH(itb_) do { const int it_ = 2 * (itb_) + half; const int ch_ = it_ / NCH, c_ = it_ % NCH, d_ = ch_ & 1, h_ = (ch_ >> 1) & 3, b_ = ch_ >> 3; \
        _Pragma("unroll") for (int r = 0; r < 2; ++r) { const int f_ = htid + 256 * r; const size_t m_ = (size_t)scan_row(b_, d_, 64 * c_ + (f_ >> 3)); \
            pk[r] = *(const u32x4*)(MKB + m_ * 256 + h_ * 64 + (f_ & 7) * 8); pv[r] = *(const u32x4*)(U + m_ * INP + UC_ML + 512 + h_ * 64 + (f_ & 7) * 8); } \
        if (hw == 0) { const size_t m_ = (size_t)scan_row(b_, d_, 64 * c_ + lane); gi = U[m_ * INP + UC_ML + 1024 + d_ * 8 + h_]; gf = U[m_ * INP + UC_ML + 1024 + d_ * 8 + 4 + h_]; } } while (0)
    u32x4 pk[2], pv[2]; bf16_t gi = 0, gf = 0;
    int itb = obid();
    if (itb < 16 * NCH) MA_FETCH(itb);
    while (itb < 16 * NCH) {
        const int item = 2 * itb + half; const int chain = item / NCH, c = item % NCH, d = chain & 1, h = (chain >> 1) & 3, b = chain >> 3;
        if (hw == 0) { const size_t m = (size_t)scan_row(b, d, 64 * c + lane);
            const float ig = bf2f(gi) + gb[d * 8 + h]; const float lf = logsig(bf2f(gf) + gb[d * 8 + 4 + h]);
            float bc = lf;
#pragma unroll
            for (int o = 1; o < 64; o <<= 1) { const float t = __shfl_up(bc, o); if (lane >= o) bc += t; }
            const float g = rlane(bc, 63);
            sWK[lane] = __expf(g - bc + ig); GT[m * 16 + d * 8 + h] = ig; GT[m * 16 + d * 8 + 4 + h] = bc;
            if (lane == 0) GX[item] = __expf(g); }
        __syncthreads();
        float pn[8];
#pragma unroll
        for (int e = 0; e < 8; ++e) pn[e] = 0.f;
#pragma unroll
        for (int r = 0; r < 2; ++r) { const int fpc = htid + 256 * r, srow = fpc >> 3, part = fpc & 7;
            const u32x4 kw = pk[r], vw = pv[r];
            const float wk = sWK[srow];
            const float kf[8] = {bflo(kw.x) * wk, bfhi(kw.x) * wk, bflo(kw.y) * wk, bfhi(kw.y) * wk, bflo(kw.z) * wk, bfhi(kw.z) * wk, bflo(kw.w) * wk, bfhi(kw.w) * wk};
            const unsigned vb[4] = {vw.x, vw.y, vw.z, vw.w};
#pragma unroll
            for (int e = 0; e < 8; ++e) { pn[e] += kf[e];
                *(LAS bf16_t*)(hb + TSZ + (part * 8 + e) * TP + srow * 2) = (bf16_t)f2bf(kf[e]);
                *(LAS bf16_t*)(hb + (part * 8 + e) * TP + srow * 2) = (bf16_t)((e & 1) ? (vb[e >> 1] >> 16) : (vb[e >> 1] & 0xffffu)); } }
#pragma unroll
        for (int e = 0; e < 8; ++e) { float v = pn[e]; v += __shfl_xor(v, 8); v += __shfl_xor(v, 16); v += __shfl_xor(v, 32); pn[e] = v; }
        if ((lane >> 3) == 0) {
#pragma unroll
            for (int e = 0; e < 8; ++e) red[hw * 64 + (lane & 7) * 8 + e] = pn[e]; }
        __syncthreads();
        const int nx = itb + G;
        if (nx < 16 * NCH) MA_FETCH(nx);
        { const int ti = hw & 1, tj = hw >> 1; const f32x16 acc = mm32(hb, hb + TSZ, 32 * ti, 32 * tj, r32, hi, zero16());
            float* dst = DC + (size_t)item * 4096 + 32 * tj + r32;
#pragma unroll
            for (int r = 0; r < 16; ++r) dst[(32 * ti + crow16(r, hi)) * 64] = acc[r];
            if (hw == 3) DN[(size_t)item * 64 + lane] = (red[lane] + red[64 + lane]) + (red[128 + lane] + red[192 + lane]); }
        __syncthreads();
        itb = nx;
    }
#undef MA_FETCH
}
__device__ __forceinline__ void mlstm_phaseB(KPP p, int chain) {
    const int tid = otid();
    const float* DC = WSP(float, WS_MLDC); const float* DN = WSP(float, WS_MLSM); float* NST = WSP(float, WS_MLSM) + 4224 * 64; const float* GX = DN + 2 * 4224 * 64; bf16_t* CS = WSP(bf16_t, WS_MLCS);
    f32x4 c0 = (f32x4){0.f, 0.f, 0.f, 0.f}, c1 = c0; float n = 0.f;
    f32x4 pa[4], pb[4]; float pg[4], pd[4];
#pragma unroll
    for (int q = 0; q < 4; ++q) { const size_t it = (size_t)chain * NCH + q; pa[q] = *(const f32x4*)(DC + it * 4096 + tid * 8); pb[q] = *(const f32x4*)(DC + it * 4096 + tid * 8 + 4); pg[q] = GX[it]; pd[q] = tid < 64 ? DN[it * 64 + tid] : 0.f; }
    for (int c4 = 0; c4 < NCH; c4 += 4) {
#pragma unroll
        for (int q = 0; q < 4; ++q) { const size_t it = (size_t)chain * NCH + c4 + q;
            u32x4 w; w.x = pk2(c0[0], c0[1]); w.y = pk2(c0[2], c0[3]); w.z = pk2(c1[0], c1[1]); w.w = pk2(c1[2], c1[3]); *(u32x4*)(CS + it * 4096 + tid * 8) = w;
            if (tid < 64) NST[it * 64 + tid] = n;
            c0 = c0 * pg[q] + pa[q]; c1 = c1 * pg[q] + pb[q]; n = n * pg[q] + pd[q];
            if (c4 + 4 + q < NCH) { const size_t nx = it + 4; pa[q] = *(const f32x4*)(DC + nx * 4096 + tid * 8); pb[q] = *(const f32x4*)(DC + nx * 4096 + tid * 8 + 4); pg[q] = GX[nx]; pd[q] = tid < 64 ? DN[nx * 64 + tid] : 0.f; } }
    }
}
constexpr int RL_AB = 0, RL_BT = TSZ, RL_KT = 2 * TSZ, RL_RB = 3 * TSZ, RL_BH = 4 * TSZ, RL_KH = 5 * TSZ, RL_VT = 6 * TSZ, RL_AK = 7 * TSZ, RL_ARB = 8 * TSZ, RL_ARK = 9 * TSZ;
constexpr int RL_WT = RL_AB, RL_UT = RL_BT;
constexpr int RL_AAB = 10 * TSZ, RL_XR = RL_AAB + 16384, XRP = 129, RL_RED = RL_XR + 64 * XRP * 4, RL_GL = RL_RED + 2048;
static_assert(RL_GL + 256 <= MISC_OFF, "rwkv phase A LDS");
__device__ __forceinline__ void rwkv_phaseA(KPP p, int l, LAS unsigned char* lds) {
    const int tid = otid(), lane = tid & 63, wave = __builtin_amdgcn_readfirstlane(tid >> 6), col = lane, rg = wave, r32 = lane & 31, hi = lane >> 5;
    float* GH = WSP(float, WS_RGH); bf16_t* RWG = WSP(bf16_t, WS_RRW); float* YP = WSP(float, WS_RYP);
    LAS float* red = (LAS float*)(lds + RL_RED); LAS float* sGL = (LAS float*)(lds + RL_GL); LAS float* XR = (LAS float*)(lds + RL_XR); LAS float* AAB = (LAS float*)(lds + RL_AAB);
#define RA_FETCH(item_) do { const int ch_ = (item_) / NCH, c_ = (item_) % NCH, d_ = ch_ & 1, h_ = (ch_ >> 1) & 3, b_ = ch_ >> 3; \
        const long o0 = (long)scan_row(b_, d_, 64 * c_ + 8 * rg) * 256 + h_ * 64 + col; const int st = d_ ? -256 : 256; \
        const float* a0 = RWA(RA_LW0 + d_) + o0; const bf16_t* a1 = RWB(RA_A0 + d_) + o0; const bf16_t* a2 = RWB(RA_KD0 + d_) + o0; const bf16_t* a3 = RWB(RA_KK) + o0; const bf16_t* a4 = RWB(RA_R) + o0; const bf16_t* a5 = RWB(RA_V) + o0; \
        _Pragma("unroll") for (int i = 0; i < 8; ++i) { lw[i] = a0[i * st]; kab[i] = a1[i * st]; kdb[i] = a2[i * st]; kkb[i] = a3[i * st]; rrb[i] = a4[i * st]; vvb[i] = a5[i * st]; } } while (0)
    float lw[8]; bf16_t kab[8], kdb[8], kkb[8], rrb[8], vvb[8];
    int item = obid();
    if (item < 32 * NCH) RA_FETCH(item);
    while (item < 32 * NCH) {
        const int chain = item / NCH, c = item % NCH, d = chain & 1, h = (chain >> 1) & 3, b = chain >> 3;
        float kk[8], ka[8], kd[8], rr[8], vv[8];
#pragma unroll
        for (int i = 0; i < 8; ++i) { ka[i] = bf2f(kab[i]); kd[i] = bf2f(kdb[i]); kk[i] = bf2f(kkb[i]); rr[i] = bf2f(rrb[i]); vv[i] = bf2f(vvb[i]); }
        asm volatile("" ::: "memory");
        float lwc[8];
#pragma unroll
        for (int i = 0; i < 8; ++i) lwc[i] = lw[i];
        float cum[8]; cum[0] = lwc[0];
#pragma unroll
        for (int i = 1; i < 8; ++i) cum[i] = cum[i - 1] + lwc[i];
        red[rg * 64 + col] = cum[7];
        __syncthreads();
        float off = 0.f, cL = 0.f;
#pragma unroll
        for (int g8 = 0; g8 < 8; ++g8) { const float t = red[g8 * 64 + col]; cL += t; off += g8 < rg ? t : 0.f; }
        float bhp[8], khp[8];
#pragma unroll
        for (int i = 0; i < 8; ++i) { const float ci = off + cum[i]; const float E = __expf(ci), Ei = __expf(-ci), Ep = __expf(ci - lwc[i]), EL = __expf(cL - ci);
            const int row = 8 * rg + i; const float ab = -kk[i] * Ep;
            *(LAS bf16_t*)(lds + RL_AB + row * TP + col * 2) = (bf16_t)f2bf(ab); *(LAS bf16_t*)(lds + RL_BT + row * TP + col * 2) = (bf16_t)f2bf(ka[i] * Ei);
            *(LAS bf16_t*)(lds + RL_KT + row * TP + col * 2) = (bf16_t)f2bf(kd[i] * Ei); *(LAS bf16_t*)(lds + RL_RB + row * TP + col * 2) = (bf16_t)f2bf(rr[i] * E);
            XR[row * XRP + col] = ab; bhp[i] = ka[i] * EL; khp[i] = kd[i] * EL; }
        { u32x4 w; w.x = pk2(bhp[0], bhp[1]); w.y = pk2(bhp[2], bhp[3]); w.z = pk2(bhp[4], bhp[5]); w.w = pk2(bhp[6], bhp[7]); *(LAS u32x4*)(lds + RL_BH + col * TP + rg * 16) = w;
          u32x4 y; y.x = pk2(khp[0], khp[1]); y.y = pk2(khp[2], khp[3]); y.z = pk2(khp[4], khp[5]); y.w = pk2(khp[6], khp[7]); *(LAS u32x4*)(lds + RL_KH + col * TP + rg * 16) = y;
          u32x4 z; z.x = pk2(vv[0], vv[1]); z.y = pk2(vv[2], vv[3]); z.z = pk2(vv[4], vv[5]); z.w = pk2(vv[6], vv[7]); *(LAS u32x4*)(lds + RL_VT + col * TP + rg * 16) = z; }
        if (rg == 0) sGL[col] = __expf(cL);
        __syncthreads();
        { const int pr = wave & 3; const LAS unsigned char* Aop = lds + (pr < 2 ? RL_AB : RL_RB); const LAS unsigned char* Bop = lds + ((pr & 1) ? RL_KT : RL_BT);
#pragma unroll
          for (int q = 0; q < 2; ++q) { const int ti = wave >> 2, tj = q; const bool zt = (ti == 0 && tj == 1);
            f32x16 acc = zero16(); if (!zt) acc = mm32(Aop, Bop, 32 * ti, 32 * tj, r32, hi, acc);
            const int sidx = 32 * tj + r32;
#pragma unroll
            for (int r = 0; r < 16; ++r) { const int t = 32 * ti + crow16(r, hi); const bool ok = pr < 2 ? (sidx < t) : (sidx <= t); const float v = (ok && !zt) ? acc[r] : 0.f;
                if (pr == 0) AAB[sidx * 64 + (t & 3) * 16 + (t >> 2)] = v;
                else *(LAS bf16_t*)(lds + (pr == 1 ? RL_AK : (pr == 2 ? RL_ARB : RL_ARK)) + t * TP + sidx * 2) = (bf16_t)f2bf(v); } } }
        __syncthreads();
        if (wave < 4) { const int ti = wave & 1, tj = wave >> 1; const f32x16 acc = mm32(lds + RL_AK, lds + RL_VT, 32 * ti, 32 * tj, r32, hi, zero16());
#pragma unroll
            for (int r = 0; r < 16; ++r) XR[(32 * ti + crow16(r, hi)) * XRP + 64 + 32 * tj + r32] = acc[r]; }
        __syncthreads();
        { const int cc = tid >> 2, ph = tid & 3; float x[16];
#pragma unroll
          for (int i = 0; i < 16; ++i) x[i] = XR[(4 * i + ph) * XRP + cc];
          asm volatile("" ::: "memory");
#define RW_SOLVE_STEP(S_) { constexpr int is_ = (S_) >> 2, ps_ = (S_) & 3; const float xs = dppf<ps_ * 0x55>(x[is_]); const LAS float* ap = AAB + (S_) * 64 + ph * 16; \
            _Pragma("unroll") for (int i4 = is_ >> 2; i4 < 4; ++i4) { const f32x4 a4 = *(const LAS f32x4*)(ap + 4 * i4); x[4 * i4] += a4[0] * xs; x[4 * i4 + 1] += a4[1] * xs; x[4 * i4 + 2] += a4[2] * xs; x[4 * i4 + 3] += a4[3] * xs; } }
#define RW_SOLVE4(S_) RW_SOLVE_STEP(S_) RW_SOLVE_STEP(S_ + 1) RW_SOLVE_STEP(S_ + 2) RW_SOLVE_STEP(S_ + 3) asm volatile("" ::: "memory");
#define RW_SOLVE16(S_) RW_SOLVE4(S_) RW_SOLVE4(S_ + 4) RW_SOLVE4(S_ + 8) RW_SOLVE4(S_ + 12)
          RW_SOLVE16(0) RW_SOLVE16(16) RW_SOLVE16(32) RW_SOLVE16(48)
#undef RW_SOLVE16
#undef RW_SOLVE4
#undef RW_SOLVE_STEP
          LAS unsigned char* tile = lds + (cc < 64 ? RL_WT : RL_UT) + (cc & 63) * TP;
#pragma unroll
          for (int i = 0; i < 16; ++i) *(LAS bf16_t*)(tile + (4 * i + ph) * 2) = (bf16_t)f2bf(x[i]); }
        __syncthreads();
        const int nitem = item + gridDim.x;
        if (nitem < 32 * NCH) RA_FETCH(nitem);
        { const int ti = wave & 1, tj = (wave >> 1) & 1; LAS float* stg = (LAS float*)(lds + RL_AAB);
          if (wave < 4) {
            f32x16 g = mm32(lds + RL_BH, lds + RL_WT, 32 * ti, 32 * tj, r32, hi, zero16());
            const int k = 32 * tj + r32; const float glk = sGL[k]; const int gb_ = ((k >> 4) * 64 + ((k >> 2) & 3) * 16) * 4 + (k & 3);
#pragma unroll
            for (int r = 0; r < 16; ++r) { const int kp = 32 * ti + crow16(r, hi); stg[gb_ + ((kp >> 4) * 256 + (kp & 15)) * 4] = g[r] + (kp == k ? glk : 0.f); }
            f32x16 w = mm32(lds + RL_ARB, lds + RL_WT, 32 * ti, 32 * tj, r32, hi, zero16());
#pragma unroll
            for (int r = 0; r < 16; ++r) { const int t = 32 * ti + crow16(r, hi); *(LAS bf16_t*)(lds + RL_AK + t * TP + k * 2) = (bf16_t)f2bf(w[r] + bf2f(*(const LAS bf16_t*)(lds + RL_RB + t * TP + k * 2))); }
          } else {
            f32x16 hh = mm32(lds + RL_KH, lds + RL_VT, 32 * ti, 32 * tj, r32, hi, zero16()); hh = mm32(lds + RL_BH, lds + RL_UT, 32 * ti, 32 * tj, r32, hi, hh);
            const int v = 32 * tj + r32; const int hb_ = 4096 + ((v >> 4) * 256 + (v & 15)) * 4;
#pragma unroll
            for (int r = 0; r < 16; ++r) { const int kp = 32 * ti + crow16(r, hi); stg[hb_ + ((kp >> 4) * 64 + ((kp >> 2) & 3) * 16) * 4 + (kp & 3)] = hh[r]; }
            f32x16 yy = mm32(lds + RL_ARK, lds + RL_VT, 32 * ti, 32 * tj, r32, hi, zero16()); yy = mm32(lds + RL_ARB, lds + RL_UT, 32 * ti, 32 * tj, r32, hi, yy);
            float* yp = YP + (size_t)item * 4096 + v;
#pragma unroll
            for (int r = 0; r < 16; ++r) yp[(32 * ti + crow16(r, hi)) * 64] = yy[r];
          } }
        __syncthreads();
        { const LAS f32x4* stg4 = (const LAS f32x4*)(lds + RL_AAB); f32x4* gdst = (f32x4*)(GH + (size_t)item * 8192);
#pragma unroll
          for (int r = 0; r < 4; ++r) gdst[tid + 512 * r] = stg4[tid + 512 * r];
          *(u32x4*)(RWG + (size_t)item * 4096 + tid * 8) = *(const LAS u32x4*)(lds + RL_AK + (tid >> 3) * TP + (tid & 7) * 16); }
        __syncthreads();
        item = nitem;
    }
#undef RA_FETCH
}
__device__ __forceinline__ void rwkv_phaseB(KPP p, int item, LAS unsigned char* lds) {
    const int chain = item >> 1, wgh = item & 1;
    const int tid = otid(), lane = tid & 63, wave = __builtin_amdgcn_readfirstlane(tid >> 6);
    const float* GH = WSP(float, WS_RGH) + (size_t)chain * NCH * 8192; bf16_t* SC = WSP(bf16_t, WS_RSC) + (size_t)chain * NCH * 4096;
    const bool loader = wave >= 4; const int lt = tid - 256;
    LAS float* xb = (LAS float*)(lds + 2 * 32768);
    f32x4 own[2], oth[2], pend[3][8];
    own[0] = own[1] = oth[0] = oth[1] = (f32x4){0.f, 0.f, 0.f, 0.f};
    if (loader) {
#pragma unroll
        for (int r = 0; r < 8; ++r) *(LAS f32x4*)(lds + (lt + 256 * r) * 16) = *(const f32x4*)(GH + (lt + 256 * r) * 4);
#pragma unroll
        for (int q = 0; q < 3; ++q)
#pragma unroll
            for (int r = 0; r < 8; ++r) pend[q][r] = *(const f32x4*)(GH + (size_t)(q + 1) * 8192 + (lt + 256 * r) * 4);
    }
    __syncthreads();
    for (int c3 = 0; c3 < NCH; c3 += 3) {
#pragma unroll
      for (int q = 0; q < 3; ++q) { const int c = c3 + q;
        if (loader) {
            if (c + 1 < NCH) {
#pragma unroll
                for (int r = 0; r < 8; ++r) *(LAS f32x4*)(lds + ((c + 1) & 1) * 32768 + (lt + 256 * r) * 16) = pend[q][r]; }
            if (c + 4 < NCH) {
#pragma unroll
                for (int r = 0; r < 8; ++r) pend[q][r] = *(const f32x4*)(GH + (size_t)(c + 4) * 8192 + (lt + 256 * r) * 4); }
        } else {
            const int vs = 2 * wgh + (wave >> 1), mh = wave & 1, n = lane & 15, qq = lane >> 4;
            const LAS float* Gs = (const LAS float*)(lds + (c & 1) * 32768); const LAS float* Hs = Gs + 4096 + vs * 1024;
            if (c > 0) { const LAS float* xp = xb + ((c & 1) * 4 + (wave ^ 1)) * 512 + lane * 4; oth[0] = *(const LAS f32x4*)xp; oth[1] = *(const LAS f32x4*)(xp + 256); }
            bf16_t* sp = SC + (size_t)c * 4096 + (16 * vs + n) * 64 + 4 * qq + 32 * mh;
#pragma unroll
            for (int t2 = 0; t2 < 2; ++t2) { u32x2 w; w.x = pk2(own[t2][0], own[t2][1]); w.y = pk2(own[t2][2], own[t2][3]); *(u32x2*)(sp + 16 * t2) = w; }
            f32x4 old[4]; old[2 * mh] = own[0]; old[2 * mh + 1] = own[1]; old[2 * (mh ^ 1)] = oth[0]; old[2 * (mh ^ 1) + 1] = oth[1];
            f32x4 nacc[2];
#pragma unroll
            for (int t2 = 0; t2 < 2; ++t2) nacc[t2] = *(const LAS f32x4*)(Hs + ((2 * mh + t2) * 64 + lane) * 4);
#pragma unroll
            for (int sg = 0; sg < 4; ++sg) { f32x4 g4[2];
#pragma unroll
                for (int t2 = 0; t2 < 2; ++t2) g4[t2] = *(const LAS f32x4*)(Gs + (((2 * mh + t2) * 4 + sg) * 64 + lane) * 4);
#pragma unroll
                for (int si = 0; si < 4; ++si)
#pragma unroll
                    for (int t2 = 0; t2 < 2; ++t2) nacc[t2] = __builtin_amdgcn_mfma_f32_16x16x4f32(g4[t2][si], old[sg][si], nacc[t2], 0, 0, 0); }
            own[0] = nacc[0]; own[1] = nacc[1];
            { LAS float* xw = xb + (((c + 1) & 1) * 4 + wave) * 512 + lane * 4; *(LAS f32x4*)xw = own[0]; *(LAS f32x4*)(xw + 256) = own[1]; }
        }
        __syncthreads();
      }
    }
}
__device__ __forceinline__ f32x4 lo4(u32x4 w) { return (f32x4){bflo(w.x), bfhi(w.x), bflo(w.y), bfhi(w.y)}; }
__device__ __forceinline__ f32x4 hi4(u32x4 w) { return (f32x4){bflo(w.z), bfhi(w.z), bflo(w.w), bfhi(w.w)}; }
__device__ __forceinline__ float sum4(f32x4 a) { return (a[0] + a[1]) + (a[2] + a[3]); }
__device__ __forceinline__ void mixer_phaseC(KPP p, int l, LAS unsigned char* lds) {
    const int tid = otid(), lane = tid & 63, wave = __builtin_amdgcn_readfirstlane(tid >> 6), half = wave >> 2, hw = wave & 3, htid = tid & 255, r32 = lane & 31, hi = lane >> 5;
    const bf16_t* U = WSP(bf16_t, WS_U); const bf16_t* MQB = WSP(bf16_t, WS_MQB); const bf16_t* MKB = WSP(bf16_t, WS_MKB); const float* GT = WSP(float, WS_GT);
    const float* NST = WSP(float, WS_MLSM) + 4224 * 64; const bf16_t* CS = WSP(bf16_t, WS_MLCS);
    const bf16_t* RWG = WSP(bf16_t, WS_RRW); const float* YP = WSP(float, WS_RYP); const bf16_t* SC = WSP(bf16_t, WS_RSC); bf16_t* MIX = WSP(bf16_t, WS_MIX);
    LAS unsigned char* hb = lds + half * 49152;
    LAS float* sBC = (LAS float*)(hb + 5 * TSZ); LAS float* sA = sBC + 64; LAS bf16_t* sN = (LAS bf16_t*)(sBC + 128);
    LAS bf16_t* ORW = (LAS bf16_t*)(lds + 98304); LAS bf16_t* OML = ORW + 2 * 4096;
    const int G = gridDim.x, d = half;
#define MX_ITEM(pidx_) ((((pidx_) / NCH) * 2 + d) * NCH + (d == 0 ? (pidx_) % NCH : (((pidx_) % NCH) < 4 ? 3 - ((pidx_) % NCH) : 135 - ((pidx_) % NCH))))
#define MX_SKIP(pidx_) (l == 1 && ((pidx_) % NCH) < 4)
#define MX_FETCH_RW(pidx_) do { const size_t it0_ = (size_t)MX_ITEM(pidx_) * 4096; \
        _Pragma("unroll") for (int r = 0; r < 2; ++r) { tr[r] = *(const u32x4*)(RWG + it0_ + (htid + 256 * r) * 8); ts[r] = *(const u32x4*)(SC + it0_ + (htid + 256 * r) * 8); } } while (0)
#define MX_FETCH_ML(pidx_) do { const int it_ = MX_ITEM(pidx_); const int c_ = it_ % NCH, bh_ = (pidx_) / NCH, h_ = bh_ & 3, b_ = bh_ >> 2; \
        _Pragma("unroll") for (int r = 0; r < 2; ++r) { const int f_ = htid + 256 * r; const size_t m_ = (size_t)scan_row(b_, d, 64 * c_ + (f_ >> 3)); \
            pq[r] = *(const u32x4*)(MQB + m_ * 256 + h_ * 64 + (f_ & 7) * 8); pk[r] = *(const u32x4*)(MKB + m_ * 256 + h_ * 64 + (f_ & 7) * 8); \
            pv[r] = *(const u32x4*)(U + m_ * INP + UC_ML + 512 + h_ * 64 + (f_ & 7) * 8); pc[r] = *(const u32x4*)(CS + (size_t)it_ * 4096 + f_ * 8); } \
        if (hw == 0) { const size_t m_ = (size_t)scan_row(b_, d, 64 * c_ + lane); gi = GT[m_ * 16 + d * 8 + h_]; gb_ = GT[m_ * 16 + d * 8 + 4 + h_]; gn = NST[(size_t)it_ * 64 + lane]; } } while (0)
    int pidx = obid(); while (pidx < 16 * NCH && MX_SKIP(pidx)) pidx += G;
    u32x4 tr[2], ts[2], pq[2], pk[2], pv[2], pc[2]; float gi = 0.f, gb_ = 0.f, gn = 0.f;
    if (pidx < 16 * NCH) { MX_FETCH_RW(pidx); MX_FETCH_ML(pidx); }
    const int ti = hw & 1, tj = hw >> 1, vcol = 32 * tj + r32;
    while (pidx < 16 * NCH) {
        const int item = MX_ITEM(pidx); const int bh = pidx / NCH, j = pidx % NCH, h = bh & 3, b = bh >> 2;
#pragma unroll
        for (int r = 0; r < 2; ++r) { const int f = htid + 256 * r; *(LAS u32x4*)(hb + (f >> 3) * TP + (f & 7) * 16) = tr[r]; *(LAS u32x4*)(hb + TSZ + (f >> 3) * TP + (f & 7) * 16) = ts[r]; }
        float ypv[16];
        { const float* yp = YP + (size_t)item * 4096 + vcol;
#pragma unroll
          for (int r = 0; r < 16; ++r) ypv[r] = yp[(32 * ti + crow16(r, hi)) * 64]; }
        __syncthreads();
        int nx = pidx + G; while (nx < 16 * NCH && MX_SKIP(nx)) nx += G;
        if (nx < 16 * NCH) MX_FETCH_RW(nx);
        { const f32x16 acc = mm32(hb, hb + TSZ, 32 * ti, 32 * tj, r32, hi, zero16());
#pragma unroll
          for (int r = 0; r < 16; ++r) ORW[d * 4096 + (32 * ti + crow16(r, hi)) * 64 + vcol] = (bf16_t)f2bf(acc[r] + ypv[r]); }
        __syncthreads();
        if (hw == 0) { sBC[lane] = gb_; sA[lane] = gi - gb_; sN[lane] = (bf16_t)f2bf(gn); }
#pragma unroll
        for (int r = 0; r < 2; ++r) { const int f = htid + 256 * r, row = f >> 3, part = f & 7;
            *(LAS u32x4*)(hb + row * TP + part * 16) = pq[r]; *(LAS u32x4*)(hb + TSZ + row * TP + part * 16) = pk[r]; *(LAS u32x4*)(hb + 3 * TSZ + row * TP + part * 16) = pc[r];
            const unsigned vb[4] = {pv[r].x, pv[r].y, pv[r].z, pv[r].w};
#pragma unroll
            for (int e = 0; e < 8; ++e) *(LAS bf16_t*)(hb + 2 * TSZ + (part * 8 + e) * TP + row * 2) = (bf16_t)((e & 1) ? (vb[e >> 1] >> 16) : (vb[e >> 1] & 0xffffu)); }
        __syncthreads();
        if (nx < 16 * NCH) MX_FETCH_ML(nx);
        { const f32x16 sacc = mm32(hb, hb + TSZ, 32 * ti, 32 * tj, r32, hi, zero16());
            const int sidx = 32 * tj + r32; const float as = sA[sidx];
#pragma unroll
            for (int r = 0; r < 16; ++r) { const int t = 32 * ti + crow16(r, hi); const float v = sidx <= t ? sacc[r] * __expf(sBC[t] + as) : 0.f; *(LAS bf16_t*)(hb + 4 * TSZ + t * TP + sidx * 2) = (bf16_t)f2bf(v); } }
        __syncthreads();
        {   const f32x16 n1 = mm32(hb + 4 * TSZ, hb + 2 * TSZ, 32 * ti, 32 * tj, r32, hi, zero16());
            const f32x16 n2 = mm32(hb, hb + 3 * TSZ, 32 * ti, 32 * tj, r32, hi, zero16());
            f32x16 d1 = zero16(), d2 = zero16(); const bf16x8 ones = (bf16x8){0x3F80, 0x3F80, 0x3F80, 0x3F80, 0x3F80, 0x3F80, 0x3F80, 0x3F80};
#pragma unroll
            for (int ks = 0; ks < 4; ++ks) { const bf16x8 a1 = *(const LAS bf16x8*)(hb + 4 * TSZ + (32 * ti + r32) * TP + ks * 32 + hi * 16), a2 = *(const LAS bf16x8*)(hb + (32 * ti + r32) * TP + ks * 32 + hi * 16);
                const bf16x8 nb = *(const LAS bf16x8*)((const LAS unsigned char*)sN + ks * 32 + hi * 16);
                d1 = __builtin_amdgcn_mfma_f32_32x32x16_bf16(a1, ones, d1, 0, 0, 0); d2 = __builtin_amdgcn_mfma_f32_32x32x16_bf16(a2, nb, d2, 0, 0, 0); }
#pragma unroll
            for (int r = 0; r < 16; ++r) { const int t = 32 * ti + crow16(r, hi); const float eb = __expf(sBC[t]);
                const float num = n1[r] + eb * n2[r], den = d1[r] + eb * d2[r];
                OML[d * 4096 + t * 64 + vcol] = (bf16_t)f2bf(num * __builtin_amdgcn_rcpf(fmaxf(fabsf(den), 1.f))); } }
        __syncthreads();
        { const int t = tid >> 3, c8 = (tid & 7) * 8; const size_t m = (size_t)(j < 4 ? NLAT + b * LC + 64 * j : b * T + 64 * (j - 4)) + t; const int ch = h * 64 + c8;
          float eps_rw = 64e-5f, eps_ml = 1e-5f; asm volatile("" : "+v"(eps_rw), "+v"(eps_ml));
          const u32x4 wr = *(const u32x4*)(RWB(RA_R) + m * 256 + ch), wv = *(const u32x4*)(RWB(RA_V) + m * 256 + ch), wg = *(const u32x4*)(RWB(RA_G) + m * 256 + ch);
          const u32x4 wk0 = *(const u32x4*)(RWB(RA_KD0) + m * 256 + ch), wk1 = *(const u32x4*)(RWB(RA_KD0 + 1) + m * 256 + ch), wo = *(const u32x4*)(U + m * INP + UC_ML + 768 + ch);
          const float* cst = p->in[I_RRK] + l * 256 + ch; const f32x4 rka = *(const f32x4*)cst, rkb = *(const f32x4*)(cst + 4);
          const float* cw_ = p->in[I_RLNW] + l * 256 + ch; const f32x4 lwa = *(const f32x4*)cw_, lwb = *(const f32x4*)(cw_ + 4);
          const float* cb_ = p->in[I_RLNB] + l * 256 + ch; const f32x4 lba = *(const f32x4*)cb_, lbb = *(const f32x4*)(cb_ + 4);
          const float* cm_ = p->in[I_MLNW] + l * 256 + ch; const f32x4 mwa = *(const f32x4*)cm_, mwb = *(const f32x4*)(cm_ + 4);
          const f32x4 ra = lo4(wr), rb = hi4(wr), va = lo4(wv), vb2 = hi4(wv);
          f32x4 acca = (f32x4){0.f, 0.f, 0.f, 0.f}, accb = acca;
#pragma unroll
          for (int dd = 0; dd < 2; ++dd) { const u32x4 wy = *(const LAS u32x4*)(ORW + dd * 4096 + (dd ? 63 - t : t) * 64 + c8); const u32x4 wkd = dd ? wk1 : wk0;
              const f32x4 ya = lo4(wy), yb = hi4(wy), ka = lo4(wkd), kb = hi4(wkd);
              const float mu = red8(sum4(ya) + sum4(yb)) * (1.f / 64.f); const f32x4 ca = ya - mu, cb = yb - mu;
              const float var = red8(sum4(ca * ca) + sum4(cb * cb)) * (1.f / 64.f); const float rs = rsqrtf(var + eps_rw);
              const float bs = red8(sum4(ra * ka * rka) + sum4(rb * kb * rkb));
              acca += ca * rs * lwa + lba + va * bs; accb += cb * rs * lwb + lbb + vb2 * bs; }
          { const f32x4 oa = acca * lo4(wg), ob = accb * hi4(wg); u32x4 w; w.x = pk2(oa[0], oa[1]); w.y = pk2(oa[2], oa[3]); w.z = pk2(ob[0], ob[1]); w.w = pk2(ob[2], ob[3]);
            *(u32x4*)(MIX + m * 1024 + 512 + ch) = w; }
          const u32x4 h0 = *(const LAS u32x4*)(OML + t * 64 + c8), h1 = *(const LAS u32x4*)(OML + 4096 + (63 - t) * 64 + c8);
          const f32x4 ha = lo4(h0) + lo4(h1), hbv = hi4(h0) + hi4(h1);
          const float mu = red8(sum4(ha) + sum4(hbv)) * (1.f / 64.f); const f32x4 ca = ha - mu, cb = hbv - mu;
          const float var = red8(sum4(ca * ca) + sum4(cb * cb)) * (1.f / 64.f); const float rs = rsqrtf(var + eps_ml);
          const f32x4 oga = lo4(wo), ogb = hi4(wo); f32x4 oa, ob;
#pragma unroll
          for (int i = 0; i < 4; ++i) { oa[i] = ca[i] * rs * mwa[i] * sigm(oga[i]); ob[i] = cb[i] * rs * mwb[i] * sigm(ogb[i]); }
          u32x4 w; w.x = pk2(oa[0], oa[1]); w.y = pk2(oa[2], oa[3]); w.z = pk2(ob[0], ob[1]); w.w = pk2(ob[2], ob[3]);
          *(u32x4*)(MIX + m * 1024 + 768 + ch) = w; }
        pidx = nx;
    }
#undef MX_ITEM
#undef MX_SKIP
#undef MX_FETCH_RW
#undef MX_FETCH_ML
}

__device__ __forceinline__ s16x4 vtr(const LAS unsigned char* ptr) { typedef short v4i16_t __attribute__((ext_vector_type(4))); return __builtin_bit_cast(s16x4, __builtin_amdgcn_ds_read_tr16_b64_v4i16((LAS v4i16_t*)ptr)); }
constexpr int AT_PITCH = 144, AT_TILE = 64 * AT_PITCH;
__device__ __forceinline__ void attn_unit(KPP p, int l, int unit, LAS unsigned char* lds) {
    const int tid = otid(), lane = tid & 63, wave = __builtin_amdgcn_readfirstlane(tid >> 6), r32 = lane & 31, hi = lane >> 5;
    const bf16_t* QR = WSP(bf16_t, WS_QR); const bf16_t* KR = WSP(bf16_t, WS_KR); const bf16_t* U = WSP(bf16_t, WS_U); bf16_t* MIX = WSP(bf16_t, WS_MIX);
    int b, kvh, t0, nl, i_lo; bool isctx;
    if (unit < 1024) { b = unit >> 8; kvh = (unit >> 7) & 1; t0 = (unit & 127) * 64; isctx = false;
        i_lo = t0 >= 128 ? 0 : (t0 >= 64 ? 1 : 2); const int i_hi = (t0 + 192 <= T) ? 4 : ((t0 + 128 <= T) ? 3 : 2); nl = i_hi - i_lo + 1; }
    else { const int u2 = unit - 1024; b = u2 >> 3; kvh = (u2 >> 2) & 1; t0 = (u2 & 3) * 64; isctx = true; nl = 0; i_lo = 0; }
    const int nt = nl + 4;
    const int hq = kvh * 4 + (wave >> 1), qoff = 32 * (wave & 1);
    const size_t qrow = (size_t)(isctx ? NLAT + b * LC : b * T) + t0 + qoff + r32;
    bf16x8 qf[4];
#pragma unroll
    for (int ds = 0; ds < 4; ++ds) qf[ds] = *(const bf16x8*)(QR + qrow * 512 + hq * 64 + 16 * ds + 8 * hi);
    const float sinkv = p->in[I_SINK][l * 8 + hq] * 1.4426950408889634f;
    float mrun = sinkv, lrun = hi == 0 ? 1.f : 0.f;
    f32x16 o[2];
#pragma unroll
    for (int r = 0; r < 16; ++r) { o[0][r] = 0.f; o[1][r] = 0.f; }
    const int skey = tid >> 3, spart = tid & 7;
    u32x4 kreg, vreg, kreg2, vreg2;
#define AT_ROWBASE(j) ((j) < nl ? b * T + t0 - 128 + 64 * (i_lo + (j)) : NLAT + b * LC + 64 * ((j) - nl))
#define AT_LOAD(KR_, VR_, j) do { const size_t rw = (size_t)(AT_ROWBASE(j) + skey); KR_ = *(const u32x4*)(KR + rw * 128 + kvh * 64 + spart * 8); VR_ = *(const u32x4*)(U + rw * INP + UC_V + kvh * 64 + spart * 8); } while (0)
#define AT_STORE(KR_, VR_, buf) do { *(LAS u32x4*)(lds + (buf) * AT_TILE + skey * AT_PITCH + spart * 16) = KR_; *(LAS u32x4*)(lds + 2 * AT_TILE + (buf) * AT_TILE + skey * AT_PITCH + spart * 16) = VR_; } while (0)
    AT_LOAD(kreg, vreg, 0); AT_STORE(kreg, vreg, 0); AT_LOAD(kreg, vreg, 1); __syncthreads();
    for (int j = 0; j < nt; ++j) {
        if (j + 2 < nt) AT_LOAD(kreg2, vreg2, j + 2);
        const LAS unsigned char* Kb = lds + (j & 1) * AT_TILE; const LAS unsigned char* Vb = lds + 2 * AT_TILE + (j & 1) * AT_TILE;
        f32x16 p0, p1;
#pragma unroll
        for (int r = 0; r < 16; ++r) { p0[r] = 0.f; p1[r] = 0.f; }
#pragma unroll
        for (int ds = 0; ds < 4; ++ds) {
            const bf16x8 a0 = *(const LAS bf16x8*)(Kb + r32 * AT_PITCH + ds * 32 + hi * 16), a1 = *(const LAS bf16x8*)(Kb + (32 + r32) * AT_PITCH + ds * 32 + hi * 16);
            p0 = __builtin_amdgcn_mfma_f32_32x32x16_bf16(a0, qf[ds], p0, 0, 0, 0); p1 = __builtin_amdgcn_mfma_f32_32x32x16_bf16(a1, qf[ds], p1, 0, 0, 0); }
        const int mtype = (j < nl) ? ((i_lo + j) == 0 ? 1 : ((i_lo + j) == 4 ? 2 : 0)) : 0;
        if (mtype != 0) { const int x = qoff + r32;
#pragma unroll
            for (int r = 0; r < 16; ++r) { const int k0 = crow16(r, hi), k1 = k0 + 32;
                const bool ok0 = mtype == 1 ? (k0 >= x) : (k0 <= x), ok1 = mtype == 1 ? (k1 >= x) : (k1 <= x);
                p0[r] = ok0 ? p0[r] : -INFINITY; p1[r] = ok1 ? p1[r] : -INFINITY; } }
        float mt = fmaxf(p0[0], p1[0]);
#pragma unroll
        for (int r = 1; r < 16; ++r) mt = fmaxf(mt, fmaxf(p0[r], p1[r]));
        mt = fmaxf(mt, __shfl_xor(mt, 32));
        const float mnew = fmaxf(mrun, mt), alpha = __builtin_amdgcn_exp2f(mrun - mnew); mrun = mnew;
        float rs = 0.f;
#pragma unroll
        for (int r = 0; r < 16; ++r) { p0[r] = __builtin_amdgcn_exp2f(p0[r] - mnew); p1[r] = __builtin_amdgcn_exp2f(p1[r] - mnew); rs += p0[r] + p1[r]; }
        lrun = lrun * alpha + rs;
#pragma unroll
        for (int r = 0; r < 16; ++r) { o[0][r] *= alpha; o[1][r] *= alpha; }
        bf16x8 pb[4];
#pragma unroll
        for (int s = 0; s < 2; ++s) {
            u32x4 w0, w1;
            w0.x = pk2(p0[8 * s], p0[8 * s + 1]); w0.y = pk2(p0[8 * s + 2], p0[8 * s + 3]); w0.z = pk2(p0[8 * s + 4], p0[8 * s + 5]); w0.w = pk2(p0[8 * s + 6], p0[8 * s + 7]);
            w1.x = pk2(p1[8 * s], p1[8 * s + 1]); w1.y = pk2(p1[8 * s + 2], p1[8 * s + 3]); w1.z = pk2(p1[8 * s + 4], p1[8 * s + 5]); w1.w = pk2(p1[8 * s + 6], p1[8 * s + 7]);
            pb[s] = __builtin_bit_cast(bf16x8, w0); pb[2 + s] = __builtin_bit_cast(bf16x8, w1); }
#pragma unroll
        for (int dblk = 0; dblk < 2; ++dblk)
#pragma unroll
            for (int ks = 0; ks < 4; ++ks) {
                const LAS unsigned char* vp = Vb + (16 * ks + 4 * hi + ((lane & 15) >> 2)) * AT_PITCH + (32 * dblk + 16 * ((lane >> 4) & 1) + 4 * (lane & 3)) * 2;
                const s16x4 t1 = vtr(vp), t2 = vtr(vp + 8 * AT_PITCH);
                const bf16x8 av = (bf16x8){t1[0], t1[1], t1[2], t1[3], t2[0], t2[1], t2[2], t2[3]};
                o[dblk] = __builtin_amdgcn_mfma_f32_32x32x16_bf16(av, pb[ks], o[dblk], 0, 0, 0); }
        if (j + 1 < nt) AT_STORE(kreg, vreg, (j + 1) & 1);
        kreg = kreg2; vreg = vreg2;
        __syncthreads();
    }
#undef AT_ROWBASE
#undef AT_LOAD
#undef AT_STORE
    const float inv = 1.f / (lrun + __shfl_xor(lrun, 32));
#pragma unroll
    for (int dblk = 0; dblk < 2; ++dblk)
#pragma unroll
        for (int g4 = 0; g4 < 4; ++g4) { const int d = 32 * dblk + 8 * g4 + 4 * hi;
            u32x2 w; w.x = pk2(o[dblk][4 * g4] * inv, o[dblk][4 * g4 + 1] * inv); w.y = pk2(o[dblk][4 * g4 + 2] * inv, o[dblk][4 * g4 + 3] * inv);
            *(u32x2*)(MIX + qrow * 1024 + hq * 64 + d) = w; }
}
__device__ __forceinline__ void phase_scan_attn(KPP p, int l, LAS unsigned char* lds) {
    const int tid = otid(), bid = obid();
    if (bid < 64) rwkv_phaseB(p, bid, lds);
    else if (bid < 96) { mlstm_phaseB(p, bid - 64); __syncthreads(); }
    unsigned* ctr = WSP(unsigned, WS_CTL) + CW_ATT + l * 64;
    volatile LAS int* misc = (volatile LAS int*)(lds + MISC_OFF);
    const int nunits = 1024 + (l == 0 ? 32 : 0);
    for (;;) { if (tid == 0) misc[0] = (int)atomicAdd(ctr, 1u); __syncthreads(); const int unit = misc[0]; __syncthreads(); if (unit >= nunits) break; attn_unit(p, l, unit, lds); }
    {
      const int wave = tid >> 6, lane = tid & 63; LAS float* scr = (LAS float*)(lds + 16384) + wave * (64 * 33);
      unsigned* wctr = WSP(unsigned, WS_CTL) + CW_ATT + l * 64 + 16; const int nit = l == 0 ? WC_N1 : WC_N2;
      for (;;) { int b0 = 0; if (lane == 0) b0 = (int)atomicAdd(wctr, 16u); b0 = __builtin_amdgcn_readfirstlane(b0); if (b0 >= nit) break;
        const int b1 = b0 + 16 < nit ? b0 + 16 : nit;
        weight_copy_run(p, l + 1, b0, b1, scr, lane); } }
}

__device__ __forceinline__ void phase_router(KPP p, int l, LAS unsigned char* lds) {
    const int tid = otid(), lane = tid & 63, wave = tid >> 6, gw = obid() * NWAVES + wave, ngw = gridDim.x * NWAVES;
    const int mhi = l == 0 ? NTOK : NLAT;
    const float* g = p->in[I_N2G] + l * 1024; const float* MOD = WSP(float, WS_MOD) + (size_t)l * 5 * 6144;
    const float* X = WSP(float, WS_X); bf16_t* H = WSP(bf16_t, WS_H);
    const float* RW = p->in[I_ROUTW] + (size_t)l * 1024 * 32; const float* RB = p->in[I_ROUTB] + l * 32;
    unsigned* cnt = WSP(unsigned, WS_CTL) + CW_CNT + l * 2048; int* list = WSP(int, WS_LIST); float* gates = WSP(float, WS_GATE);
    LAS unsigned* lcnt = (LAS unsigned*)(lds + 131072); LAS unsigned* lbase = lcnt + 32; LAS unsigned* lnent = lcnt + 64; LAS unsigned* lent = lcnt + 128;
    if (tid < 32) lcnt[tid] = 0u; if (tid == 32) *lnent = 0u;
    { const int rot = (obid() * 37) & 1023;
      for (int f0 = tid; f0 < 8192; f0 += NTHR) { const int f = (f0 + rot * 8) & 8191; const int k = f >> 3, c = f & 7; *(LAS f32x4*)(lds + k * 128 + ((c ^ ((k >> 1) & 7)) << 4)) = *(const f32x4*)(RW + (size_t)f * 4); } }
    __syncthreads();
    float nx0[16], nx1[16];
    if (gw < mhi / 2) { const float* q0 = X + (size_t)(gw * 2) * D + lane;
#pragma unroll
        for (int jj = 0; jj < 16; ++jj) { nx0[jj] = q0[64 * jj]; nx1[jj] = q0[D + 64 * jj]; } }
    for (int pi = gw; pi < mhi / 2; pi += ngw) {
        const int m0 = pi * 2; const int mr = m0 < NLAT ? (m0 >> 13) : 4; const float* shift = MOD + mr * 6144 + 3 * 1024; const float* scale = MOD + mr * 6144 + 4 * 1024;
        bf16_t* hp0 = H + (size_t)m0 * D + lane; bf16_t* hp1 = hp0 + D;
        const float* scp = scale + lane; const float* shp = shift + lane; const float* gp = g + lane;
        float x0[16], x1[16]; float s0 = 0.f, s1 = 0.f;
#pragma unroll
        for (int jj = 0; jj < 16; ++jj) { x0[jj] = nx0[jj]; x1[jj] = nx1[jj]; s0 += x0[jj] * x0[jj]; s1 += x1[jj] * x1[jj]; }
        if (pi + ngw < mhi / 2) { const float* q0 = X + (size_t)((pi + ngw) * 2) * D + lane;
#pragma unroll
            for (int jj = 0; jj < 16; ++jj) { nx0[jj] = q0[64 * jj]; nx1[jj] = q0[D + 64 * jj]; } }
        const float r0 = rsqrtf(wsum(s0) * (1.f / 1024.f) + 1e-6f), r1 = rsqrtf(wsum(s1) * (1.f / 1024.f) + 1e-6f);
        float v[64];
#pragma unroll
        for (int e = 0; e < 64; ++e) v[e] = 0.f;
        const LAS unsigned char* wbase = lds + lane * 128; const int sw = (lane >> 1) & 7;
#pragma unroll
        for (int jj = 0; jj < 16; ++jj) { const float sc = scp[64 * jj] + 1.f, sh = shp[64 * jj], gkk = gp[64 * jj];
            const float h0 = (x0[jj] * r0 * gkk) * sc + sh, h1 = (x1[jj] * r1 * gkk) * sc + sh;
            hp0[64 * jj] = (bf16_t)f2bf(h0); hp1[64 * jj] = (bf16_t)f2bf(h1);
#pragma unroll
            for (int q = 0; q < 8; ++q) { const f32x4 w4 = *(const LAS f32x4*)(wbase + jj * 8192 + ((q ^ sw) << 4));
#pragma unroll
                for (int i = 0; i < 4; ++i) { v[4 * q + i] += h0 * w4[i]; v[32 + 4 * q + i] += h1 * w4[i]; } }
            if ((jj & 3) == 3) asm volatile("" ::: "memory"); }
#pragma unroll
        for (int o = 32; o >= 1; o >>= 1) { const bool up = (lane & o) != 0;
#pragma unroll
            for (int i = 0; i < o; ++i) { const float send = up ? v[i] : v[i + o], keep = up ? v[i + o] : v[i]; v[i] = keep + __shfl_xor(send, o); if ((i & 7) == 7) asm volatile("" ::: "memory"); } }
        const int e = lane & 31; float val = v[0] + RB[e];
        int sel[4]; float sv[4];
#pragma unroll
        for (int r = 0; r < 4; ++r) { float mx = val;
#pragma unroll
            for (int o = 16; o >= 1; o >>= 1) mx = fmaxf(mx, __shfl_xor(mx, o));
            const unsigned long long bal = __builtin_amdgcn_ballot_w64(val == mx);
            const unsigned half = (unsigned)(lane < 32 ? bal : (bal >> 32));
            const int w = __builtin_ctz(half); sel[r] = w; sv[r] = mx; if (e == w) val = -INFINITY; }
        const float e1 = __expf(sv[1] - sv[0]), e2 = __expf(sv[2] - sv[0]), e3 = __expf(sv[3] - sv[0]); const float inv = 1.f / (1.f + e1 + e2 + e3);
        const float gv[4] = {inv, e1 * inv, e2 * inv, e3 * inv};
        if (e == 0) { const int m = m0 + (lane >> 5);
#pragma unroll
            for (int r = 0; r < 4; ++r) { const unsigned lr = __hip_atomic_fetch_add(lcnt + sel[r], 1u, __ATOMIC_RELAXED, __HIP_MEMORY_SCOPE_WORKGROUP);
                const unsigned slot = __hip_atomic_fetch_add(lnent, 1u, __ATOMIC_RELAXED, __HIP_MEMORY_SCOPE_WORKGROUP);
                lent[2 * slot] = ((unsigned)sel[r] << 24) | lr; lent[2 * slot + 1] = (unsigned)(m * 4 + r); gates[m * 4 + r] = gv[r]; } }
    }
    __syncthreads();
    if (tid < 32) lbase[tid] = atomicAdd(cnt + tid * 64, lcnt[tid]);
    __syncthreads();
    { const unsigned nent = *lnent;
      for (unsigned i = tid; i < nent; i += NTHR) { const unsigned w = lent[2 * i]; const unsigned e = w >> 24; list[(size_t)e * CAP + lbase[e] + (w & 0xFFFFFFu)] = (int)lent[2 * i + 1]; } }
}

__device__ __forceinline__ void phase_combine(KPP p, int l) {
    const int lane = otid() & 63, wave = otid() >> 6, gw = obid() * NWAVES + wave, ngw = gridDim.x * NWAVES;
    const int mhi = l == 0 ? NTOK : NLAT;
    const float* MOD = WSP(float, WS_MOD) + (size_t)l * 5 * 6144; float* X = WSP(float, WS_X); const bf16_t* YK = WSP(bf16_t, WS_YK);
    f32x4 px[4]; u32x2 py[4][4];
#define CB_FETCH(m_) do { _Pragma("unroll") for (int j = 0; j < 4; ++j) { const int k = 4 * (lane + 64 * j); px[j] = *(const f32x4*)(X + (size_t)(m_) * D + k); \
        _Pragma("unroll") for (int r = 0; r < 4; ++r) py[j][r] = *(const u32x2*)(YK + (size_t)((m_) * 4 + r) * 1024 + k); } } while (0)
    if (gw < mhi) CB_FETCH(gw);
    for (int m = gw; m < mhi; m += ngw) {
        const int mr = m < NLAT ? (m >> 13) : 4; const float* g2 = MOD + mr * 6144 + 5 * 1024;
        f32x4 v[4];
#pragma unroll
        for (int j = 0; j < 4; ++j) { const int k = 4 * (lane + 64 * j); f32x4 s = (f32x4){0.f, 0.f, 0.f, 0.f};
#pragma unroll
            for (int r = 0; r < 4; ++r) s += (f32x4){bflo(py[j][r].x), bfhi(py[j][r].x), bflo(py[j][r].y), bfhi(py[j][r].y)};
            v[j] = px[j] + *(const f32x4*)(g2 + k) * s; }
        if (m + ngw < mhi) CB_FETCH(m + ngw);
        if (l == 0) {
#pragma unroll
            for (int j = 0; j < 4; ++j) *(f32x4*)(X + (size_t)m * D + 4 * (lane + 64 * j)) = v[j];
            const float* MOD1 = WSP(float, WS_MOD) + (size_t)5 * 6144;
            norm_mod_store(v, p->in[I_N1G] + 1024, MOD1 + mr * 6144, MOD1 + mr * 6144 + 1024, WSP(bf16_t, WS_H) + (size_t)m * D, lane);
        } else {
            float ss = 0.f;
#pragma unroll
            for (int j = 0; j < 4; ++j) ss += (v[j][0] * v[j][0] + v[j][1] * v[j][1]) + (v[j][2] * v[j][2] + v[j][3] * v[j][3]);
            const float rstd = rsqrtf(wsum(ss) * (1.f / 1024.f) + 1e-6f);
#pragma unroll
            for (int j = 0; j < 4; ++j) { const int k = 4 * (lane + 64 * j); *(f32x4*)(p->out + (size_t)m * D + k) = v[j] * rstd * *(const f32x4*)(p->in[I_FNG] + k); }
        }
    }
#undef CB_FETCH
}

__device__ __forceinline__ void moe_prefix(KPP p, int l, LAS int* tp) {
    if (otid() == 0) { const unsigned* cnt = WSP(unsigned, WS_CTL) + CW_CNT + l * 2048; int s = 0;
        for (int e = 0; e < 32; ++e) { tp[e] = s; s += ((int)cnt[e * 64] + 255) >> 8; } tp[32] = s; }
    __syncthreads();
}

constexpr int N_PHASES = 22;
template <int PH> __device__ __forceinline__ void run_phase(KPP p, int l, LAS unsigned char* lds) {
    if constexpr (PH == 0) phase_p0a(p, lds);
    if constexpr (PH == 1) phase_norm1(p, 0, p->in[I_X], p->in[I_CTX]);
    if constexpr (PH == 2) {
        pg8::DenseOrder S; S.init(NTOK, INP, gridDim.x, obid(), WSP(bf16_t, WS_WIN) + (size_t)l * INP * 1024);
        pg8::EpiInProj E{WSP(bf16_t, WS_U)};
        pg8::gemm_phase(lds, WSP(const unsigned char, WS_H), S, E); }
    if constexpr (PH == 3) { phase_prep(p, l, lds); __syncthreads(); mlstm_phaseA(p, l, lds); }
    if constexpr (PH == 12) rwkv_phaseA(p, l, lds);
    if constexpr (PH == 11) mixer_phaseC(p, l, lds);
    if constexpr (PH == 4) phase_scan_attn(p, l, lds);
    if constexpr (PH == 6) {
        pg8::DenseOrder S; S.init(l == 0 ? NTOK : NLAT, D, gridDim.x, obid(), WSP(bf16_t, WS_WOUT) + (size_t)l * 1024 * 1024);
        pg8::EpiOutProj E{l == 0 ? p->in[I_X] : WSP(const float, WS_X), l == 0 ? p->in[I_CTX] : WSP(const float, WS_X) + (size_t)NLAT * D, WSP(float, WS_X), WSP(const float, WS_MOD) + (size_t)l * 5 * 6144};
        pg8::gemm_phase(lds, WSP(const unsigned char, WS_MIX), S, E); }
    if constexpr (PH == 7) phase_router(p, l, lds);
    if constexpr (PH == 8) {
        LAS int* tp = (LAS int*)(lds + MISC_OFF); moe_prefix(p, l, tp);
        pg8::MoeOrder S{tp, WSP(const int, WS_LIST), WSP(const int, WS_CTL) + CW_CNT + l * 2048, 8, (int)gridDim.x, (int)obid(), 2,
                        WSP(const unsigned char, WS_W1) + (size_t)l * 32 * 2048 * 1024 * 2, (size_t)2048 * 1024 * 2};
        pg8::EpiMoe1 E{WSP(const int, WS_LIST), p->in[I_B1] + (size_t)l * 32 * 2048, WSP(bf16_t, WS_HB)};
        pg8::gemm_phase(lds, WSP(const unsigned char, WS_H), S, E); }
    if constexpr (PH == 9) {
        LAS int* tp = (LAS int*)(lds + MISC_OFF); moe_prefix(p, l, tp);
        pg8::MoeOrder S{tp, WSP(const int, WS_LIST), WSP(const int, WS_CTL) + CW_CNT + l * 2048, 4, (int)gridDim.x, (int)obid(), 0,
                        WSP(const unsigned char, WS_W2) + (size_t)l * 32 * 1024 * 1024 * 2, (size_t)1024 * 1024 * 2};
        pg8::EpiMoe2 E{WSP(const int, WS_LIST), p->in[I_B2] + (size_t)l * 32 * 1024, WSP(const float, WS_GATE), WSP(bf16_t, WS_YK)};
        pg8::gemm_phase(lds, WSP(const unsigned char, WS_HB), S, E); }
    if constexpr (PH == 10) phase_combine(p, l);
}
__global__ void __launch_bounds__(NTHR, 2) mk_fwd(KP p_unused) {
    extern __shared__ __attribute__((aligned(16))) unsigned char lds_raw[];
    LAS unsigned char* lds = (LAS unsigned char*)lds_raw;
    cg::grid_group grid = cg::this_grid();
    { KPP p = kp_ptr(); if (otid() < 2) ((volatile LAS unsigned*)(lds + BAR_ST_OFF))[otid()] = 0u; __syncthreads(); xcd_barrier_post(WSP(unsigned, WS_CTL) + CW_BAR); }
    int ph = 0;
#define PHASE(PH, l) do { KPP p = kp_ptr(); if (ph >= p->ph_lo && ph < p->ph_hi) { run_phase<PH>(p, l, lds); if (ph + 1 < p->ph_hi) { if (p->ph_hi > 1000) grid.sync(); else xcd_barrier(WSP(unsigned, WS_CTL) + CW_BAR, lds); } } ++ph; } while (0)
    PHASE(0, 0); PHASE(1, 0);
    for (int l = 0; l < 2; ++l) { PHASE(2, l); PHASE(3, l); PHASE(12, l); PHASE(4, l); PHASE(11, l); PHASE(6, l); PHASE(7, l); PHASE(8, l); PHASE(9, l); PHASE(10, l); }
#undef PHASE
}

#ifndef MK_PER_PHASE
#define MK_PER_PHASE 0
#endif
extern "C" void kernel_launch(void* const* d_in, const int* in_sizes, int n_in, void* d_out, int out_size, void* d_ws, size_t ws_size, hipStream_t stream) {
    static int grid = 0;
    if (grid == 0) {
        if (n_in != 35 || out_size != NLAT * D || ws_size < WS_END) { fprintf(stderr, "kernel_launch: unexpected sizes n_in %d out %d ws %zu (need %zu)\n", n_in, out_size, ws_size, (size_t)WS_END); grid = -1; return; }
        int dev = 0, cus = 0, per_cu = 0;
        (void)hipGetDevice(&dev); (void)hipDeviceGetAttribute(&cus, hipDeviceAttributeMultiprocessorCount, dev);
        (void)hipFuncSetAttribute((const void*)mk_fwd, hipFuncAttributeMaxDynamicSharedMemorySize, LDS_BYTES);
        (void)hipOccupancyMaxActiveBlocksPerMultiprocessor(&per_cu, (const void*)mk_fwd, NTHR, LDS_BYTES);
        if (per_cu < 1) { fprintf(stderr, "kernel_launch: occupancy query says %d blocks per CU\n", per_cu); grid = -1; return; }
        grid = cus > 0 ? cus : 256;
        (void)hipGetLastError();
    }
    if (grid < 0) return;
    (void)hipMemsetAsync((char*)d_ws + WS_CTL, 0, CTL_ZERO_BYTES, stream);
    KP p{};
    for (int i = 0; i < 35; ++i) p.in[i] = (const float*)d_in[i];
    p.out = (float*)d_out; p.ws = (unsigned char*)d_ws;
#if MK_PER_PHASE
    for (int ph = 0; ph < N_PHASES; ++ph) { p.ph_lo = ph; p.ph_hi = ph + 1; void* args[] = {&p};
        hipError_t e = hipLaunchCooperativeKernel((const void*)mk_fwd, dim3(grid), dim3(NTHR), args, LDS_BYTES, stream);
        if (e != hipSuccess) { fprintf(stderr, "launch %d failed: %s\n", ph, hipGetErrorString(e)); break; } }
#else
    p.ph_lo = 0; p.ph_hi = N_PHASES; void* args[] = {&p};
    hipError_t e = hipLaunchCooperativeKernel((const void*)mk_fwd, dim3(grid), dim3(NTHR), args, LDS_BYTES, stream);
    if (e != hipSuccess) fprintf(stderr, "cooperative launch failed: %s (grid %d)\n", hipGetErrorString(e), grid);
#endif
}
```

```cpp
#include <hip/hip_runtime.h>
#include <hip/hip_cooperative_groups.h>
#include <cstdio>
#include <cstdint>
namespace cg = cooperative_groups;

#define LAS __attribute__((address_space(3)))
typedef unsigned short bf16_t;
typedef unsigned u32x4 __attribute__((ext_vector_type(4)));
typedef unsigned u32x2 __attribute__((ext_vector_type(2)));
typedef float f32x4 __attribute__((ext_vector_type(4)));
typedef float f32x2 __attribute__((ext_vector_type(2)));
typedef short bf16x8 __attribute__((ext_vector_type(8)));
typedef float f32x16 __attribute__((ext_vector_type(16)));
typedef short s16x4 __attribute__((ext_vector_type(4)));

constexpr int D = 1024, NB = 4, T = 8192, LC = 256;
constexpr int NLAT = NB * T, NCTX = NB * LC, NTOK = NLAT + NCTX;
constexpr int INW = 2768, INP = 2816;
constexpr int UC_Q = 0, UC_K = 512, UC_V = 640, UC_RW = 768, UC_ML = 1728, UC_HV = 2784;
constexpr int NE = 32, CAP = NTOK;
constexpr int NWAVES = 8, NTHR = 512;
constexpr int LDS_BYTES = 147456;
constexpr float QSCALE = 0.125f * 1.4426950408889634f;
constexpr int MISC_OFF = 146432;

constexpr size_t MiB = 1u << 20;
constexpr size_t WS_CTL = 0, CTL_ZERO_BYTES = 65536;
constexpr size_t WS_MOD = 1 * MiB;
constexpr size_t WS_ROPE = 1 * MiB + 512 * 1024;
constexpr size_t WS_GATE = 2 * MiB;
constexpr size_t WS_LIST = 3 * MiB;
constexpr size_t WS_WIN = 8 * MiB;
constexpr size_t WS_WOUT = 20 * MiB;
constexpr size_t WS_W1 = 24 * MiB;
constexpr size_t WS_W2 = 280 * MiB;
constexpr size_t WS_X = 408 * MiB;
constexpr size_t WS_H = 540 * MiB;
constexpr size_t WS_MIX = 606 * MiB;
constexpr size_t WS_VF = 672 * MiB;
constexpr size_t WS_SCR = 706 * MiB;
constexpr size_t WS_U = WS_SCR;
constexpr size_t WS_QR = WS_SCR + 182 * MiB;
constexpr size_t WS_KR = WS_SCR + 215 * MiB;
constexpr size_t WS_RWA = WS_SCR + 224 * MiB;
constexpr size_t RWA_STRIDE = 33 * MiB;
enum { RA_R = 0, RA_V, RA_KK, RA_G, RA_LW0, RA_LW1, RA_A0, RA_A1, RA_KD0, RA_KD1, RA_Y0, RA_Y1 };
constexpr size_t WS_MQ = WS_SCR + 620 * MiB;
constexpr size_t WS_MK = WS_SCR + 653 * MiB;
constexpr size_t WS_GT = WS_SCR + 686 * MiB;
constexpr size_t WS_GL = WS_SCR + 689 * MiB;
constexpr size_t WS_HB = WS_SCR;
constexpr size_t WS_YK = WS_SCR + 264 * MiB;
constexpr size_t WS_MLDC = WS_SCR + 758 * MiB;
constexpr size_t WS_MLCS = WS_SCR + 830 * MiB;
constexpr size_t WS_MLSM = WS_SCR + 866 * MiB;
constexpr size_t WS_MQB = WS_SCR + 870 * MiB;
constexpr size_t WS_MKB = WS_SCR + 887 * MiB;
constexpr size_t WS_RGH = WS_SCR + 904 * MiB;
constexpr size_t WS_RRW = WS_SCR + 1036 * MiB;
constexpr size_t WS_RYP = WS_SCR + 1069 * MiB;
constexpr size_t WS_RSC = WS_SCR + 1135 * MiB;
constexpr size_t WS_END = WS_SCR + 1168 * MiB;
constexpr int CW_CNT = 8192;
constexpr int CW_ATT = 128;

struct KP {
    const float* in[35];
    float* out;
    unsigned char* ws;
    int ph_lo, ph_hi;
};
enum { I_X = 0, I_C, I_CTX, I_CCTX, I_N1G, I_N2G, I_ADAW, I_ADAB, I_WIN, I_WOUT, I_SINK, I_RCONV, I_RW0, I_RWUP, I_RA0, I_RAUP, I_RGUP, I_RKK, I_RKA, I_RRK,
       I_RLNW, I_RLNB, I_RV0, I_RVDOWN, I_RVUP, I_MCONV, I_MGB, I_MLNW, I_ROUTW, I_ROUTB, I_W1, I_B1, I_W2, I_B2, I_FNG };

typedef const __attribute__((address_space(4))) KP* KPP;
__device__ __forceinline__ int otid() { int t = __builtin_amdgcn_workitem_id_x(); asm volatile("" : "+v"(t)); return t; }
__device__ __forceinline__ int obid() { int b = __builtin_amdgcn_workgroup_id_x(); asm volatile("" : "+s"(b)); return b; }
__device__ __forceinline__ KPP kp_ptr() { KPP q = (KPP)__builtin_amdgcn_kernarg_segment_ptr(); asm volatile("" : "+s"(q)); return q; }
typedef __bf16 hwbf16x2 __attribute__((ext_vector_type(2)));
__device__ __forceinline__ unsigned pk2(float lo, float hi) { const f32x2 v = {lo, hi}; const hwbf16x2 b = __builtin_convertvector(v, hwbf16x2); return __builtin_bit_cast(unsigned, b); }
__device__ __forceinline__ unsigned f2bf(float f) { return pk2(f, f) & 0xffffu; }
__device__ __forceinline__ float bf2f(bf16_t b) { return __uint_as_float(((unsigned)b) << 16); }
__device__ __forceinline__ float bflo(unsigned w) { return __uint_as_float(w << 16); }
__device__ __forceinline__ float bfhi(unsigned w) { return __uint_as_float(w & 0xffff0000u); }
__device__ __forceinline__ float sigm(float x) { return __builtin_amdgcn_rcpf(1.f + __expf(-x)); }
__device__ __forceinline__ float wsum(float v) {
#pragma unroll
    for (int o = 32; o; o >>= 1) v += __shfl_xor(v, o);
    return v;
}
__device__ __forceinline__ float wmax(float v) {
#pragma unroll
    for (int o = 32; o; o >>= 1) v = fmaxf(v, __shfl_xor(v, o));
    return v;
}
__device__ __forceinline__ float gsum16(float v) {
#pragma unroll
    for (int o = 8; o; o >>= 1) v += __shfl_xor(v, o);
    return v;
}
__device__ __forceinline__ float rlane(float x, int k) { return __int_as_float(__builtin_amdgcn_readlane(__float_as_int(x), k)); }
#define LDS_FENCE() asm volatile("s_waitcnt lgkmcnt(0)" ::: "memory")

#define XB_TMO      128
#define XB_XCNT(j)  (256  + 64 * (j))
#define XB_XSUB(j)  (1280 + 64 * (j))
#define XB_XGEN(j)  (2304 + 64 * (j))
#define XB_TOP      3328
#define XB_TOPGEN   3392
#define XCD_BAR_WORDS 3456
#define XB_SPIN_CAP (1u << 20)
constexpr int CW_BAR = 4096;
constexpr int BAR_ST_OFF = MISC_OFF + 256;
__device__ __forceinline__ unsigned xb_ld(unsigned* p)              { return __hip_atomic_load(p, __ATOMIC_RELAXED, __HIP_MEMORY_SCOPE_AGENT); }
__device__ __forceinline__ unsigned xb_add(unsigned* p, unsigned v) { return __hip_atomic_fetch_add(p, v, __ATOMIC_RELAXED, __HIP_MEMORY_SCOPE_AGENT); }
__device__ __forceinline__ unsigned xb_xcc_id() { return (unsigned)__builtin_amdgcn_s_getreg((3 << 11) | 20) & 0xFu; }
#define XB_SPIN(cond, bar) do { unsigned _sp = 0; while (cond) { __builtin_amdgcn_s_sleep(1); \
    if ((++_sp & 255u) == 0u) { if (xb_ld(&(bar)[XB_TMO])) break; if (_sp > XB_SPIN_CAP) { atomicAdd(&(bar)[XB_TMO], 1u); break; } } } } while (0)
__device__ __forceinline__ void xcd_barrier_post(unsigned* bar) { if (otid() == 0) (void)xb_add(&bar[XB_XCNT(xb_xcc_id())], 1u); }
__device__ __forceinline__ void xcd_barrier_complete(unsigned* bar, unsigned x, unsigned& nloc, unsigned& nx) {
    const unsigned G = gridDim.x;
    unsigned sum, cnt, mine, sp = 0u;
    for (;;) {
        sum = 0u; cnt = 0u; mine = 0u;
#pragma unroll
        for (unsigned j = 0; j < 16; ++j) { const unsigned c = xb_ld(&bar[XB_XCNT(j)]); sum += c; cnt += (c > 0u) ? 1u : 0u; mine = (j == x) ? c : mine; }
        if (sum == G) break;
        __builtin_amdgcn_s_sleep(1);
        if ((++sp & 255u) == 0u) { if (xb_ld(&bar[XB_TMO])) break; if (sp > XB_SPIN_CAP) { atomicAdd(&bar[XB_TMO], 1u); break; } }
    }
    nloc = mine > 0u ? mine : 1u; nx = cnt > 0u ? cnt : 1u;
}
__device__ __forceinline__ void xcd_barrier(unsigned* bar, LAS unsigned char* lds) {
    asm volatile("s_waitcnt vmcnt(0)" ::: "memory");
    __syncthreads();
    if (otid() == 0) {
        volatile LAS unsigned* st = (volatile LAS unsigned*)(lds + BAR_ST_OFF);
        const unsigned x = xb_xcc_id();
        __builtin_amdgcn_s_waitcnt(0);
        unsigned nloc = st[0], nx = st[1];
        if (nloc == 0u) { xcd_barrier_complete(bar, x, nloc, nx); st[0] = nloc; st[1] = nx; }
        const unsigned old = xb_add(&bar[XB_XSUB(x)], 1u);
        const unsigned gen = old / nloc;
        if (old + 1u == (gen + 1u) * nloc) {
            __builtin_amdgcn_fence(__ATOMIC_RELEASE, "agent");
            asm volatile("s_waitcnt vmcnt(0)" ::: "memory");
            const unsigned og = xb_add(&bar[XB_TOP], 1u);
            const unsigned tg = og / nx;
            if (og + 1u == (tg + 1u) * nx) xb_add(&bar[XB_TOPGEN], 1u);
            else XB_SPIN(xb_ld(&bar[XB_TOPGEN]) == tg, bar);
            __builtin_amdgcn_fence(__ATOMIC_ACQUIRE, "agent");
            xb_add(&bar[XB_XGEN(x)], 1u);
            asm volatile("s_waitcnt vmcnt(0)" ::: "memory");
        } else {
            XB_SPIN(xb_ld(&bar[XB_XGEN(x)]) == gen, bar);
            __builtin_amdgcn_fence(__ATOMIC_ACQUIRE, "agent");
            asm volatile("s_waitcnt vmcnt(0)" ::: "memory");
        }
    }
    __syncthreads();
}


namespace pg8 {
constexpr int BM = 256, BK = 64, HALF = 128, HTB = HALF * BK * 2, KD = 1024, NT = KD / BK;
__host__ __device__ __forceinline__ int lds_byte(int r, int c) { const int st = (r >> 4) * 2 + (c >> 5), rr = r & 15, cc = c & 31, ob = rr * 64 + cc * 2; return st * 1024 + (ob ^ (((ob >> 9) & 1) << 5)); }
__host__ __device__ __forceinline__ void stage_rc(int b, int& R, int& C) { const int st = b / 1024, sb = b % 1024, swz = sb ^ (((sb >> 9) & 1) << 5); R = (st >> 1) * 16 + swz / 64; C = (st & 1) * 32 + (swz % 64) / 2; }
__host__ __device__ __forceinline__ int perm32(int rho) { const int n = rho >> 4, i = rho & 15; return 8 * (i >> 2) + 4 * n + (i & 3); }
struct Unit { int pm, pn, e, rows; };

struct DenseOrder {
    int nM, nN, nwg, G, c; const unsigned char* Bt;
    __device__ void init(int M, int N, int G_, int c_, const void* Bt_) { nM = M / BM; nN = N / BM; nwg = nM * nN; G = G_; c = c_; Bt = (const unsigned char*)Bt_; }
    __device__ __forceinline__ bool next(int i, Unit& u) const {
        const long L = (long)i * G + c; if (L >= nwg) return false;
        int wgid = (int)L; { const int q = nwg / 8, r = nwg % 8, xcd = wgid % 8, off = wgid / 8; wgid = (xcd < r ? xcd * (q + 1) : r * (q + 1) + (xcd - r) * q) + off; }
        const int nig = 8 * nN, gid = wgid / nig, fm = gid * 8, gsz = (nM - fm) < 8 ? (nM - fm) : 8;
        u.pm = fm + ((wgid % nig) % gsz); u.pn = (wgid % nig) / gsz; u.e = 0; u.rows = 256; return true;
    }
    __device__ __forceinline__ unsigned arow_off(const Unit& u, int r) const { return (unsigned)(u.pm * BM + r) * (unsigned)(KD * 2); }
    __device__ __forceinline__ const unsigned char* bbase(const Unit& u) const { return Bt + (size_t)u.pn * BM * KD * 2; }
    __device__ __forceinline__ void stage_rows(LAS unsigned char*, int, int, int) const {}
    __device__ __forceinline__ bool rows_in_lds(int) const { return false; }
    __device__ __forceinline__ unsigned arow_off_l(const Unit& u, int r, const LAS unsigned char*, int) const { return arow_off(u, r); }
};
struct MoeOrder {
    const LAS int* tp; const int* list; const int* cnt; int npn, G, c, shift; const unsigned char* Bt; size_t bstride;
    __device__ __forceinline__ bool next(int i, Unit& u) const {
        int tl;
        if (G == 256) {
            const int x = c & 7, j = c >> 3, lg = npn == 8 ? 3 : 2, T8 = (tp[32] + 7) >> 3, q = i * (32 >> lg) + (j >> lg);
            u.pn = j & (npn - 1); tl = x * T8 + q;
            if (q >= T8 || tl >= tp[32]) return false;
        } else { const long L = (long)i * G + c; const int total = tp[32] * npn; if (L >= total) return false; tl = (int)(L / npn); u.pn = (int)(L % npn); }
        int e = 0;
#pragma unroll
        for (int j = 0; j < 32; ++j) e += (tp[j + 1] <= tl) ? 1 : 0;
        e = __builtin_amdgcn_readfirstlane(e); u.e = e; u.pm = __builtin_amdgcn_readfirstlane(tl - tp[e]); u.pn = __builtin_amdgcn_readfirstlane(u.pn);
        const int rem = cnt[e * 64] - u.pm * BM; u.rows = __builtin_amdgcn_readfirstlane(rem < BM ? rem : BM); return true;
    }
    __device__ __forceinline__ unsigned arow_off(const Unit& u, int r) const {
        const int idx = u.pm * BM + (r < u.rows ? r : 0);
        if (shift == 0) return (unsigned)(tp[96 + u.e] + idx) * (unsigned)(KD * 2);
        const int entry = list[(size_t)u.e * CAP + idx]; return (unsigned)(entry >> shift) * (unsigned)(KD * 2);
    }
    __device__ __forceinline__ const unsigned char* bbase(const Unit& u) const { return Bt + (size_t)u.e * bstride + (size_t)u.pn * BM * KD * 2; }
    static constexpr int ROWS_OFF = 131072 + 8192;
    __device__ __forceinline__ void stage_rows(LAS unsigned char* lds, int ui, int wid, int lane) const {
        if (shift == 0) return;
        Unit u2; const bool ok = next(ui + 2, u2);
        if (ok && wid == 3) __builtin_amdgcn_global_load_lds((const unsigned*)(list + (size_t)u2.e * CAP + u2.pm * BM + 4 * lane), (LAS unsigned*)(lds + ROWS_OFF + ((ui + 2) % 3) * 1024), 16, 0, 0);
    }
    __device__ __forceinline__ bool rows_in_lds(int ui) const { return shift != 0 && ui >= 1; }
    __device__ __forceinline__ unsigned arow_off_l(const Unit& u, int r, const LAS unsigned char* lds, int slot) const {
        const LAS int* ll = (const LAS int*)(lds + ROWS_OFF + slot * 1024); const int entry = ll[r < u.rows ? r : 0]; return (unsigned)(entry >> shift) * (unsigned)(KD * 2);
    }
};

template <class Epi, class Sched>
__device__ __forceinline__ void gemm_phase(LAS unsigned char* lds, const unsigned char* Abase, const Sched& S, const Epi& E) {
    const int tid = otid(), wid = __builtin_amdgcn_readfirstlane(tid >> 6), lane = tid & 63, wr = wid >> 2, wc = wid & 3, fr = lane & 15, fq = lane >> 4;
    constexpr int nt = NT;
    unsigned voffB[2];
#pragma unroll
    for (int i = 0; i < 2; ++i) { int R, C; stage_rc(tid * 16 + i * 8192, R, C); const int Rb = Epi::PERM ? ((R & ~31) + perm32(R & 31)) : R; voffB[i] = (unsigned)(Rb * KD + C) * 2u; }
#define PG8_AOFF(dst, U_) do { _Pragma("unroll") for (int i_ = 0; i_ < 2; ++i_) { int R_, C_; stage_rc(otid() * 16 + i_ * 8192, R_, C_); _Pragma("unroll") for (int h_ = 0; h_ < 2; ++h_) dst[h_][i_] = S.arow_off(U_, h_ * HALF + R_) + (unsigned)C_ * 2u; } } while (0)
    const size_t kstep = (size_t)(BK * 2);
    const size_t hstep = (size_t)HALF * KD * 2;
    const unsigned ldsw = (unsigned)wid * 1024u;
    const int aoff = lds_byte(wr * 64 + fr, fq * 8), boff = lds_byte(wc * 32 + fr, fq * 8);
#define PG8_SA(b, h) (((b) * 2 + (h)) * HTB)
#define PG8_SB(b, h) ((4 + (b) * 2 + (h)) * HTB)
#define PG8_STAGE(bufoff, gbase, voff) do { _Pragma("unroll") for (int _i = 0; _i < 2; ++_i) \
        __builtin_amdgcn_global_load_lds((const unsigned*)((const unsigned char*)(gbase) + (voff)[_i]), (LAS unsigned*)(lds + (bufoff) + ldsw + _i * 8192), 16, 0, 0); } while (0)
#define PG8_LDA(dst, b, h) do { _Pragma("unroll") for (int m = 0; m < 4; ++m) _Pragma("unroll") for (int k = 0; k < 2; ++k) dst[m][k] = *(const LAS bf16x8*)(lds + PG8_SA(b, h) + aoff + m * 2048 + k * 1024); } while (0)
#define PG8_LDB(dst, b, h) do { _Pragma("unroll") for (int n = 0; n < 2; ++n) _Pragma("unroll") for (int k = 0; k < 2; ++k) dst[n][k] = *(const LAS bf16x8*)(lds + PG8_SB(b, h) + boff + n * 2048 + k * 1024); } while (0)
#define PG8_MMA(ai, bj, At, Bt) do { __builtin_amdgcn_s_setprio(1); _Pragma("unroll") for (int m = 0; m < 4; ++m) _Pragma("unroll") for (int n = 0; n < 2; ++n) _Pragma("unroll") for (int k = 0; k < 2; ++k) \
        acc[ai][bj][m][n] = __builtin_amdgcn_mfma_f32_16x16x32_bf16(Bt[n][k], At[m][k], acc[ai][bj][m][n], 0, 0, 0); __builtin_amdgcn_s_setprio(0); } while (0)
#define PG8_WAIT_V(n) asm volatile("s_waitcnt vmcnt(" #n ")" ::: "memory")
#define PG8_WAIT_L(n) asm volatile("s_waitcnt lgkmcnt(" #n ")" ::: "memory")
#define PG8_BAR __builtin_amdgcn_s_barrier()
#define PG8_SCHED __builtin_amdgcn_sched_barrier(0)
    Unit cur, nxt; int ui = 0;
    if (!S.next(0, cur)) return;
    f32x4 acc[2][2][4][2];
#pragma unroll
    for (int a = 0; a < 2; ++a)
#pragma unroll
        for (int b = 0; b < 2; ++b)
#pragma unroll
            for (int m = 0; m < 4; ++m)
#pragma unroll
                for (int n = 0; n < 2; ++n) acc[a][b][m][n] = (f32x4){0.f, 0.f, 0.f, 0.f};
    bf16x8 At[4][2], B0[2][2], B1[2][2];
    unsigned vA[2][2], nvA[2][2];
    PG8_AOFF(vA, cur);
    const unsigned char* cB = S.bbase(cur);
    PG8_STAGE(PG8_SB(0, 0), cB, voffB); PG8_STAGE(PG8_SB(0, 1), cB + hstep, voffB); PG8_STAGE(PG8_SA(0, 0), Abase, vA[0]); PG8_STAGE(PG8_SA(0, 1), Abase, vA[1]);
    if (wr == 1) PG8_BAR;
    PG8_WAIT_V(2); PG8_BAR;
    PG8_STAGE(PG8_SB(1, 0), cB + kstep, voffB); PG8_STAGE(PG8_SA(1, 0), Abase + kstep, vA[0]); PG8_STAGE(PG8_SB(1, 1), cB + hstep + kstep, voffB);
    PG8_WAIT_V(6); PG8_BAR;
    for (;;) {
        E.prefetch(cur, lds, ui, wid, lane);
        const bool has_next = S.next(ui + 1, nxt);
        const unsigned char* nB = has_next ? S.bbase(nxt) : cB;
        S.stage_rows(lds, ui, wid, lane);
        if (has_next) { if (S.rows_in_lds(ui)) { const int slot_ = (ui + 1) % 3;
#pragma unroll
                for (int i_ = 0; i_ < 2; ++i_) { int R_, C_; stage_rc(otid() * 16 + i_ * 8192, R_, C_);
#pragma unroll
                    for (int h_ = 0; h_ < 2; ++h_) nvA[h_][i_] = S.arow_off_l(nxt, h_ * HALF + R_, lds, slot_) + (unsigned)C_ * 2u; } }
            else PG8_AOFF(nvA, nxt); } else {
#pragma unroll
            for (int h = 0; h < 2; ++h)
#pragma unroll
                for (int i = 0; i < 2; ++i) nvA[h][i] = vA[h][i]; }
        for (int t = 0; t < nt; t += 2) {
            const bool last = (t == nt - 2);
            const unsigned char* a1 = Abase + (size_t)(t + 1) * kstep;
            const unsigned char* a2 = last ? Abase : Abase + (size_t)(t + 2) * kstep;
            const unsigned char* b2 = last ? nB : cB + (size_t)(t + 2) * kstep;
            const unsigned char* a3 = a2 + kstep; const unsigned char* b3 = b2 + kstep;
            unsigned wA0[2], wA1[2];
#pragma unroll
            for (int i = 0; i < 2; ++i) { wA0[i] = last ? nvA[0][i] : vA[0][i]; wA1[i] = last ? nvA[1][i] : vA[1][i]; }
            int post_epi = __builtin_amdgcn_readfirstlane(((t == 0) && (ui > 0)) ? 1 : 0); asm volatile("" : "+s"(post_epi));
#define PG8_WAIT_V8E do { if (post_epi) { if constexpr (Epi::NVM == 16) PG8_WAIT_V(24); else PG8_WAIT_V(16); } else PG8_WAIT_V(8); } while (0)
            PG8_LDB(B0, 0, 0); PG8_LDB(B1, 0, 1); PG8_SCHED; PG8_LDA(At, 0, 0); PG8_STAGE(PG8_SA(1, 1), a1, vA[1]);
            PG8_WAIT_V8E; PG8_WAIT_L(0); PG8_BAR; PG8_MMA(0, 0, At, B0); PG8_MMA(0, 1, At, B1); PG8_BAR; PG8_SCHED;
            PG8_LDA(At, 0, 1); PG8_STAGE(PG8_SB(0, 0), b2, voffB); PG8_STAGE(PG8_SB(0, 1), b2 + hstep, voffB); PG8_STAGE(PG8_SA(0, 0), a2, wA0);
            PG8_WAIT_V8E; PG8_WAIT_L(0); PG8_BAR; PG8_MMA(1, 0, At, B0); PG8_MMA(1, 1, At, B1); PG8_BAR; PG8_SCHED;
#undef PG8_WAIT_V8E
            PG8_LDB(B0, 1, 0); PG8_LDB(B1, 1, 1); PG8_SCHED; PG8_LDA(At, 1, 0); PG8_STAGE(PG8_SA(0, 1), a2, wA1);
            PG8_WAIT_V(8); PG8_WAIT_L(0); PG8_BAR; PG8_MMA(0, 0, At, B0); PG8_MMA(0, 1, At, B1); PG8_BAR; PG8_SCHED;
            PG8_LDA(At, 1, 1); PG8_STAGE(PG8_SB(1, 0), b3, voffB); PG8_STAGE(PG8_SB(1, 1), b3 + hstep, voffB); PG8_STAGE(PG8_SA(1, 0), a3, wA0);
            PG8_WAIT_V(8); PG8_WAIT_L(0); PG8_BAR; PG8_MMA(1, 0, At, B0); PG8_MMA(1, 1, At, B1); PG8_BAR; PG8_SCHED;
        }
        if (wr == 0) PG8_BAR;
        E(acc, cur, wr, wc, fr, fq, lds, ui);
        if (!has_next) break;
#pragma unroll
        for (int a = 0; a < 2; ++a)
#pragma unroll
            for (int b = 0; b < 2; ++b)
#pragma unroll
                for (int m = 0; m < 4; ++m)
#pragma unroll
                    for (int n = 0; n < 2; ++n) acc[a][b][m][n] = (f32x4){0.f, 0.f, 0.f, 0.f};
        cur = nxt; cB = nB; ++ui;
#pragma unroll
        for (int h = 0; h < 2; ++h)
#pragma unroll
            for (int i = 0; i < 2; ++i) vA[h][i] = nvA[h][i];
        if (wr == 1) PG8_BAR;
    }
    PG8_WAIT_V(0);
    PG8_BAR;
#undef PG8_AOFF
#undef PG8_SA
#undef PG8_SB
#undef PG8_STAGE
#undef PG8_LDA
#undef PG8_LDB
#undef PG8_MMA
#undef PG8_WAIT_V
#undef PG8_WAIT_L
#undef PG8_BAR
#undef PG8_SCHED
}
}

namespace pg8 {
struct EpiInProj {
    static constexpr bool PERM = true; static constexpr int NVM = 16;
    bf16_t* O;
    __device__ __forceinline__ void prefetch(const Unit&, LAS unsigned char*, int, int, int) const {}
    __device__ __forceinline__ void operator()(const f32x4 (&acc)[2][2][4][2], const Unit& u, int wr, int wc, int fr, int fq, LAS unsigned char* lds, int ui) const {
        asm volatile("" : "+v"(fr), "+v"(fq));
        const int row0 = u.pm * BM + wr * 64 + fr, col0 = u.pn * BM + wc * 32 + 8 * fq;
#pragma unroll
        for (int ai = 0; ai < 2; ++ai)
#pragma unroll
            for (int m = 0; m < 4; ++m) { bf16_t* rowp = O + (size_t)(row0 + ai * HALF + m * 16) * INP + col0;
#pragma unroll
                for (int bj = 0; bj < 2; ++bj) { const f32x4 v0 = acc[ai][bj][m][0], v1 = acc[ai][bj][m][1];
                    u32x4 w; w.x = pk2(v0[0], v0[1]); w.y = pk2(v0[2], v0[3]); w.z = pk2(v1[0], v1[1]); w.w = pk2(v1[2], v1[3]);
                    *(u32x4*)(rowp + bj * HALF) = w; } }
    }
};
struct EpiOutProj {
    static constexpr bool PERM = true; static constexpr int NVM = 16;
    const float* xlat; const float* xctx; bf16_t* xbuf; const float* mod; int l;
    __device__ __forceinline__ void prefetch(const Unit& u, LAS unsigned char* lds, int ui, int wid, int lane) const {
        const int rowt = u.pm * BM; const int mrow = rowt < NLAT ? (rowt >> 13) : 4;
        if (wid == 0) __builtin_amdgcn_global_load_lds((const unsigned*)(mod + mrow * 6144 + 2 * 1024 + u.pn * BM + 4 * lane), (LAS unsigned*)(lds + 131072 + (ui & 1) * 1024), 16, 0, 0);
    }
    __device__ __forceinline__ void operator()(const f32x4 (&acc)[2][2][4][2], const Unit& u, int wr, int wc, int fr, int fq, LAS unsigned char* lds, int ui) const {
        asm volatile("" : "+v"(fr), "+v"(fq));
        const int rowt = u.pm * BM; const int mrow = rowt < NLAT ? (rowt >> 13) : 4;
        bf16_t* dst = xbuf + (size_t)rowt * D;
        const int cb = u.pn * BM + wc * 32 + 8 * fq;
        const LAS float* gate = (const LAS float*)(lds + 131072 + (ui & 1) * 1024) + wc * 32 + 8 * fq;
        f32x4 g[2][2];
#pragma unroll
        for (int bj = 0; bj < 2; ++bj)
#pragma unroll
            for (int n = 0; n < 2; ++n) g[bj][n] = *(const LAS f32x4*)(gate + bj * HALF + n * 4);
        if (l == 0) {
            const float* src = rowt < NLAT ? xlat + (size_t)rowt * D : xctx + (size_t)(rowt - NLAT) * D;
#pragma unroll
            for (int ai = 0; ai < 2; ++ai) {
                f32x4 xv[4][2][2];
#pragma unroll
                for (int m = 0; m < 4; ++m)
#pragma unroll
                    for (int bj = 0; bj < 2; ++bj)
#pragma unroll
                        for (int n = 0; n < 2; ++n) xv[m][bj][n] = *(const f32x4*)(src + (size_t)(ai * HALF + wr * 64 + m * 16 + fr) * D + cb + bj * HALF + n * 4);
#pragma unroll
                for (int m = 0; m < 4; ++m)
#pragma unroll
                    for (int bj = 0; bj < 2; ++bj) { const f32x4 v0 = xv[m][bj][0] + g[bj][0] * acc[ai][bj][m][0], v1 = xv[m][bj][1] + g[bj][1] * acc[ai][bj][m][1];
                        u32x4 w; w.x = pk2(v0[0], v0[1]); w.y = pk2(v0[2], v0[3]); w.z = pk2(v1[0], v1[1]); w.w = pk2(v1[2], v1[3]);
                        *(u32x4*)(dst + (size_t)(ai * HALF + wr * 64 + m * 16 + fr) * D + cb + bj * HALF) = w; }
            }
        } else {
#pragma unroll
            for (int ai = 0; ai < 2; ++ai) {
                u32x4 xb[4][2];
#pragma unroll
                for (int m = 0; m < 4; ++m)
#pragma unroll
                    for (int bj = 0; bj < 2; ++bj) xb[m][bj] = *(const u32x4*)(dst + (size_t)(ai * HALF + wr * 64 + m * 16 + fr) * D + cb + bj * HALF);
#pragma unroll
                for (int m = 0; m < 4; ++m)
#pragma unroll
                    for (int bj = 0; bj < 2; ++bj) { const u32x4 q = xb[m][bj];
                        const f32x4 v0 = (f32x4){bflo(q.x), bfhi(q.x), bflo(q.y), bfhi(q.y)} + g[bj][0] * acc[ai][bj][m][0], v1 = (f32x4){bflo(q.z), bfhi(q.z), bflo(q.w), bfhi(q.w)} + g[bj][1] * acc[ai][bj][m][1];
                        u32x4 w; w.x = pk2(v0[0], v0[1]); w.y = pk2(v0[2], v0[3]); w.z = pk2(v1[0], v1[1]); w.w = pk2(v1[2], v1[3]);
                        *(u32x4*)(dst + (size_t)(ai * HALF + wr * 64 + m * 16 + fr) * D + cb + bj * HALF) = w; }
            }
        }
    }
};
__device__ __forceinline__ float swiglu(float g, float l) { g = fminf(g, 7.f); l = fminf(fmaxf(l, -7.f), 7.f); return g * sigm(1.702f * g) * (l + 1.f); }
__device__ __forceinline__ unsigned swiglu_pk(float g0, float l0, float g1, float l1) {
    g0 = __builtin_amdgcn_fmed3f(g0, -20.f, 7.f); g1 = __builtin_amdgcn_fmed3f(g1, -20.f, 7.f); l0 = __builtin_amdgcn_fmed3f(l0, -7.f, 7.f); l1 = __builtin_amdgcn_fmed3f(l1, -7.f, 7.f);
    const float d0 = 1.f + __builtin_amdgcn_exp2f(-2.4554669595930156f * g0), d1 = 1.f + __builtin_amdgcn_exp2f(-2.4554669595930156f * g1);
    const float r = __builtin_amdgcn_rcpf(d0 * d1);
    return pk2(g0 * (r * d1) * (l0 + 1.f), g1 * (r * d0) * (l1 + 1.f));
}
struct EpiMoe1 {
    static constexpr bool PERM = true; static constexpr int NVM = 8;
    const LAS int* tp; const float* b1; bf16_t* H;
    __device__ __forceinline__ void prefetch(const Unit& u, LAS unsigned char* lds, int ui, int wid, int lane) const {
        if (wid == 0) { const float* src = b1 + (size_t)u.e * 2048 + u.pn * 128 + (lane < 32 ? 4 * lane : 1024 + 4 * (lane - 32));
            __builtin_amdgcn_global_load_lds((const unsigned*)src, (LAS unsigned*)(lds + 131072 + (ui & 1) * 1024), 16, 0, 0); }
    }
    __device__ __forceinline__ void operator()(const f32x4 (&acc)[2][2][4][2], const Unit& u, int wr, int wc, int fr, int fq, LAS unsigned char* lds, int ui) const {
        asm volatile("" : "+v"(fr), "+v"(fq));
        const int hc = u.pn * 128 + wc * 32 + 8 * fq;
        const LAS float* bg = (const LAS float*)(lds + 131072 + (ui & 1) * 1024) + wc * 32 + 8 * fq; const LAS float* bl = bg + 128;
        const f32x4 bg0 = *(const LAS f32x4*)bg, bg1 = *(const LAS f32x4*)(bg + 4), bl0 = *(const LAS f32x4*)bl, bl1 = *(const LAS f32x4*)(bl + 4);
#pragma unroll
        for (int ai = 0; ai < 2; ++ai)
#pragma unroll
            for (int m = 0; m < 4; ++m) { const int r = ai * HALF + wr * 64 + m * 16 + fr;
                { const int entry = tp[96 + u.e] + u.pm * BM + (r < u.rows ? r : 0);
                    const f32x4 g0 = acc[ai][0][m][0] + bg0, g1 = acc[ai][0][m][1] + bg1, l0 = acc[ai][1][m][0] + bl0, l1 = acc[ai][1][m][1] + bl1;
                    u32x4 w; w.x = swiglu_pk(g0[0], l0[0], g0[1], l0[1]); w.y = swiglu_pk(g0[2], l0[2], g0[3], l0[3]);
                    w.z = swiglu_pk(g1[0], l1[0], g1[1], l1[1]); w.w = swiglu_pk(g1[2], l1[2], g1[3], l1[3]);
                    *(u32x4*)(H + (size_t)entry * 1024 + hc) = w; } }
    }
};
struct EpiMoe2 {
    static constexpr bool PERM = true; static constexpr int NVM = 16;
    const int* list; const float* b2; const float* gl; bf16_t* YK;
    __device__ __forceinline__ void prefetch(const Unit& u, LAS unsigned char* lds, int ui, int wid, int lane) const {
        LAS unsigned char* slot = lds + 131072 + (ui & 1) * 3072;
        if (wid == 0) __builtin_amdgcn_global_load_lds((const unsigned*)(b2 + (size_t)u.e * 1024 + u.pn * BM + 4 * lane), (LAS unsigned*)slot, 16, 0, 0);
        if (wid == 1) __builtin_amdgcn_global_load_lds((const unsigned*)(list + (size_t)u.e * CAP + u.pm * BM + 4 * lane), (LAS unsigned*)(slot + 1024), 16, 0, 0);
        if (wid == 2) __builtin_amdgcn_global_load_lds((const unsigned*)(gl + (size_t)u.e * CAP + u.pm * BM + 4 * lane), (LAS unsigned*)(slot + 2048), 16, 0, 0);
    }
    __device__ __forceinline__ void operator()(const f32x4 (&acc)[2][2][4][2], const Unit& u, int wr, int wc, int fr, int fq, LAS unsigned char* lds, int ui) const {
        asm volatile("" : "+v"(fr), "+v"(fq));
        const int c0 = u.pn * BM + wc * 32 + 8 * fq;
        const LAS unsigned char* slot = lds + 131072 + (ui & 1) * 3072;
        const LAS float* bb = (const LAS float*)slot + wc * 32 + 8 * fq;
        f32x4 bv[2][2];
#pragma unroll
        for (int bj = 0; bj < 2; ++bj) { bv[bj][0] = *(const LAS f32x4*)(bb + bj * HALF); bv[bj][1] = *(const LAS f32x4*)(bb + bj * HALF + 4); }
        const LAS int* le = (const LAS int*)(slot + 1024); const LAS float* lg = (const LAS float*)(slot + 2048);
#pragma unroll
        for (int ai = 0; ai < 2; ++ai)
#pragma unroll
            for (int m = 0; m < 4; ++m) { const int r = ai * HALF + wr * 64 + m * 16 + fr;
                { const int rr = r < u.rows ? r : 0; const int entry = le[rr]; const float g = lg[rr];
#pragma unroll
                    for (int bj = 0; bj < 2; ++bj) { const f32x4 v0 = (acc[ai][bj][m][0] + bv[bj][0]) * g, v1 = (acc[ai][bj][m][1] + bv[bj][1]) * g;
                        u32x4 w; w.x = pk2(v0[0], v0[1]); w.y = pk2(v0[2], v0[3]); w.z = pk2(v1[0], v1[1]); w.w = pk2(v1[2], v1[3]);
                        *(u32x4*)(YK + (size_t)entry * 1024 + c0 + bj * HALF) = w; } } }
    }
};
}

#define WSP(T_, off) ((T_*)(p->ws + (off)))
#define RWA(i) WSP(float, WS_RWA + (size_t)(i) * RWA_STRIDE)
#define RWB(i) WSP(bf16_t, WS_RWA + (size_t)(i) * RWA_STRIDE)

__device__ __forceinline__ void transpose_item(const float* W, int ldw, int n0, int nvalid, int k0, bf16_t* WT, int drow0, LAS float* scr, int lane) {
    const int kk = lane >> 3, nq = (lane & 7) * 4; const bool ok = n0 + nq < nvalid;
    f32x4 v[8];
#pragma unroll
    for (int i = 0; i < 8; ++i) v[i] = ok ? __builtin_nontemporal_load((const f32x4*)(W + (size_t)(k0 + kk + 8 * i) * ldw + n0 + nq)) : (f32x4){0.f, 0.f, 0.f, 0.f};
#pragma unroll
    for (int i = 0; i < 8; ++i) { LAS float* d = scr + (kk + 8 * i) * 33 + nq; d[0] = v[i][0]; d[1] = v[i][1]; d[2] = v[i][2]; d[3] = v[i][3]; }
    LDS_FENCE();
    const int c = lane & 7;
#pragma unroll
    for (int j = 0; j < 4; ++j) { const int nn = (lane >> 3) + 8 * j; const LAS float* s = scr + (8 * c) * 33 + nn;
        u32x4 o; o.x = pk2(s[0], s[33]); o.y = pk2(s[66], s[99]); o.z = pk2(s[132], s[165]); o.w = pk2(s[198], s[231]);
        *(u32x4*)(WT + (size_t)(drow0 + nn) * 1024 + k0 + 8 * c) = o; }
    LDS_FENCE();
}
constexpr int WC_N0 = 1408, WC_N1 = 1408 + 512 + 32768 + 16384, WC_N2 = 512 + 32768 + 16384;
__device__ __forceinline__ void weight_copy_item(KPP p, int set, int it, LAS float* scr, int lane) {
    int r = it, l = set == 2 ? 1 : 0;
    if (set <= 1) { const int lw = set;
        if (set == 0 || r < 1408) { const int kb = r / 88, nb = r % 88; bf16_t* dst = WSP(bf16_t, WS_WIN) + (size_t)lw * INP * 1024;
            if (nb < 87) transpose_item(p->in[I_WIN] + (size_t)lw * 1024 * INW, INW, nb * 32, INW, kb * 64, dst, nb * 32, scr, lane);
            else transpose_item(p->in[I_RVDOWN], 32, 0, lw == 1 ? 32 : 0, kb * 64, dst, UC_HV, scr, lane);
            return; }
        r -= 1408; }
    if (r < 512) { const int kb = r / 32, nb = r % 32;
        transpose_item(p->in[I_WOUT] + (size_t)l * 1024 * 1024, 1024, nb * 32, 1024, kb * 64, WSP(bf16_t, WS_WOUT) + (size_t)l * 1024 * 1024, nb * 32, scr, lane); return; }
    r -= 512;
    if (r < 32768) { const int le = l * 32 + r / 1024, q = r % 1024, kb = q / 64, nb = q % 64, n0 = nb * 32;
        const int drow = n0 < 1024 ? 256 * (n0 / 128) + (n0 % 128) : 256 * ((n0 - 1024) / 128) + 128 + ((n0 - 1024) % 128);
        transpose_item(p->in[I_W1] + (size_t)le * 1024 * 2048, 2048, n0, 2048, kb * 64, WSP(bf16_t, WS_W1) + (size_t)le * 2048 * 1024, drow, scr, lane); return; }
    r -= 32768;
    { const int le = l * 32 + r / 512, q = r % 512, kb = q / 32, nb = q % 32;
        transpose_item(p->in[I_W2] + (size_t)le * 1024 * 1024, 1024, nb * 32, 1024, kb * 64, WSP(bf16_t, WS_W2) + (size_t)le * 1024 * 1024, nb * 32, scr, lane); }
}
__device__ __forceinline__ void phase_p0a(KPP p, LAS unsigned char* lds) {
    const int tid = otid(), lane = tid & 63, wave = tid >> 6;
    const int gw = obid() * NWAVES + wave, ngw = gridDim.x * NWAVES;
    float* MOD = WSP(float, WS_MOD);
    LAS float* sc = (LAS float*)(lds + 90112);
    if (obid() < 192) {
        for (int i = tid; i < 5 * 1024; i += NTHR) { const int r = i >> 10, k = i & 1023; const float cv = r < 4 ? p->in[I_C][r * 1024 + k] : p->in[I_CCTX][k]; sc[k * 8 + r] = cv * sigm(cv); }
        __syncthreads(); }
    for (int it = obid(); it < 192; it += gridDim.x) {
        const int l = it / 96, cb = it % 96, n = cb * 64 + lane;
        const float* W = p->in[I_ADAW] + (size_t)l * 1024 * 6144;
        float acc[5] = {0.f, 0.f, 0.f, 0.f, 0.f};
#pragma unroll 1
        for (int k32 = wave * 128; k32 < wave * 128 + 128; k32 += 32) {
            float w[32];
#pragma unroll
            for (int q = 0; q < 32; ++q) w[q] = W[(size_t)(k32 + q) * 6144 + n];
#pragma unroll
            for (int q = 0; q < 32; ++q) { const LAS float* sk = sc + (k32 + q) * 8; const f32x4 s4 = *(const LAS f32x4*)sk; const float s5 = sk[4];
                acc[0] += s4[0] * w[q]; acc[1] += s4[1] * w[q]; acc[2] += s4[2] * w[q]; acc[3] += s4[3] * w[q]; acc[4] += s5 * w[q]; }
        }
        LAS float* red = (LAS float*)lds;
#pragma unroll
        for (int r = 0; r < 5; ++r) red[(wave * 5 + r) * 64 + lane] = acc[r];
        __syncthreads();
        if (wave < 5) { float s = 0.f;
#pragma unroll
            for (int w = 0; w < 8; ++w) s += red[(w * 5 + wave) * 64 + lane];
            MOD[(size_t)(l * 5 + wave) * 6144 + n] = s + p->in[I_ADAB][l * 6144 + n]; }
        __syncthreads();
    }
    { const int gt = obid() * NTHR + tid; if (gt < 2048) { const int pos = gt >> 4, f = gt & 15;
        const float inv = powf(10000.f, -(float)f / 16.f); const float ang = (float)pos * inv; float* RT = WSP(float, WS_ROPE); RT[gt * 2] = cosf(ang); RT[gt * 2 + 1] = sinf(ang); } }
    LAS float* scr = (LAS float*)(lds + 16384) + wave * (64 * 33);
    for (int it = gw; it < 1408; it += ngw) weight_copy_item(p, 0, it, scr, lane);
}

__device__ __forceinline__ void norm_mod_store(const f32x4 (&v)[4], const float* g, const float* shift, const float* scale, bf16_t* orow, int lane) {
    float ss = 0.f;
#pragma unroll
    for (int j = 0; j < 4; ++j) ss += (v[j][0] * v[j][0] + v[j][1] * v[j][1]) + (v[j][2] * v[j][2] + v[j][3] * v[j][3]);
    const float rstd = rsqrtf(wsum(ss) * (1.f / 1024.f) + 1e-6f);
#pragma unroll
    for (int j = 0; j < 4; ++j) { const int k = 4 * (lane + 64 * j);
        const f32x4 gg = *(const f32x4*)(g + k), sh = *(const f32x4*)(shift + k), sc = *(const f32x4*)(scale + k);
        const f32x4 o = (v[j] * rstd * gg) * (sc + 1.f) + sh;
        u32x2 w; w.x = pk2(o[0], o[1]); w.y = pk2(o[2], o[3]); *(u32x2*)(orow + k) = w; }
}
__device__ __forceinline__ void norm_mod_store_r(const f32x4 (&v)[4], const f32x4 (&gg)[4], const f32x4 (&sh)[4], const f32x4 (&sc)[4], bf16_t* orow, int lane) {
    float ss = 0.f;
#pragma unroll
    for (int j = 0; j < 4; ++j) ss += (v[j][0] * v[j][0] + v[j][1] * v[j][1]) + (v[j][2] * v[j][2] + v[j][3] * v[j][3]);
    const float rstd = rsqrtf(wsum(ss) * (1.f / 1024.f) + 1e-6f);
#pragma unroll
    for (int j = 0; j < 4; ++j) { const int k = 4 * (lane + 64 * j);
        const f32x4 o = (v[j] * rstd * gg[j]) * (sc[j] + 1.f) + sh[j];
        u32x2 w; w.x = pk2(o[0], o[1]); w.y = pk2(o[2], o[3]); *(u32x2*)(orow + k) = w; }
}
__device__ __forceinline__ void phase_norm1(KPP p, int l, const float* xlat, const float* xctx) {
    const int lane = otid() & 63, wave = otid() >> 6, gw = obid() * NWAVES + wave, ngw = gridDim.x * NWAVES;
    const float* g = p->in[I_N1G] + l * 1024; const float* MOD = WSP(float, WS_MOD) + (size_t)l * 5 * 6144; bf16_t* H = WSP(bf16_t, WS_H);
    f32x4 nv[4];
#define N1_FETCH(m_) do { const float* xr_ = (m_) < NLAT ? xlat + (size_t)(m_) * D : xctx + (size_t)((m_) - NLAT) * D; _Pragma("unroll") for (int j = 0; j < 4; ++j) nv[j] = *(const f32x4*)(xr_ + 4 * (lane + 64 * j)); } while (0)
    if (gw < NTOK) N1_FETCH(gw);
    f32x4 gg[4];
#pragma unroll
    for (int j = 0; j < 4; ++j) gg[j] = *(const f32x4*)(g + 4 * (lane + 64 * j));
    for (int m = gw; m < NTOK; m += ngw) {
        const int mr = m < NLAT ? (m >> 13) : 4;
        f32x4 v[4], sh[4], sc[4];
#pragma unroll
        for (int j = 0; j < 4; ++j) { v[j] = nv[j]; sh[j] = *(const f32x4*)(MOD + mr * 6144 + 4 * (lane + 64 * j)); sc[j] = *(const f32x4*)(MOD + mr * 6144 + 1024 + 4 * (lane + 64 * j)); }
        asm volatile("" ::: "memory");
        if (m + ngw < NTOK) N1_FETCH(m + ngw);
        norm_mod_store_r(v, gg, sh, sc, H + (size_t)m * D, lane);
    }
#undef N1_FETCH
}

__device__ __forceinline__ void seq_info(int m, int& pos, int& len) { if (m < NLAT) { pos = m & (T - 1); len = T; } else { pos = (m - NLAT) & (LC - 1); len = LC; } }
__device__ __forceinline__ f32x4 ld4bf(const bf16_t* ptr) { const u32x2 w = *(const u32x2*)ptr; return (f32x4){bflo(w.x), bfhi(w.x), bflo(w.y), bfhi(w.y)}; }
__device__ __forceinline__ void st4bf(bf16_t* ptr, f32x4 v) { u32x2 w; w.x = pk2(v[0], v[1]); w.y = pk2(v[2], v[3]); *(u32x2*)ptr = w; }

__device__ __forceinline__ void phase_prep(KPP p, int l, LAS unsigned char* lds) {
    const int tid = otid(), lane = tid & 63, wave = tid >> 6;
    const int gw = obid() * NWAVES + wave, ngw = gridDim.x * NWAVES;
    const int gt = obid() * NTHR + tid, ngt = gridDim.x * NTHR;
    const bf16_t* U = WSP(bf16_t, WS_U);
    { const float* RT = WSP(float, WS_ROPE); bf16_t* QR = WSP(bf16_t, WS_QR); bf16_t* KR = WSP(bf16_t, WS_KR);
      u32x4 nw[4];
#define RP_FETCH(idx_) do { const int m_ = (idx_) / 20, r_ = (idx_) % 20, hh_ = r_ >> 1, a_ = r_ & 1; const bf16_t* src_ = U + (size_t)m_ * INP + (hh_ < 8 ? hh_ * 64 : 512 + (hh_ - 8) * 64) + a_ * 32; \
        _Pragma("unroll") for (int q = 0; q < 4; ++q) nw[q] = ((const u32x4*)src_)[q]; } while (0)
      if (gt < NTOK * 20) RP_FETCH(gt);
      for (int idx = gt; idx < NTOK * 20; idx += ngt) {
        const int m = idx / 20, r = idx % 20, hh = r >> 1, a = r & 1;
        u32x4 w[4];
#pragma unroll
        for (int q = 0; q < 4; ++q) w[q] = nw[q];
        f32x2 csv[16];
        if (m < NLAT) { const int t = m & (T - 1); const int pos = a == 0 ? (t >> 6) : (t & 63); const f32x2* cs = (const f32x2*)(RT + pos * 32);
#pragma unroll
            for (int f = 0; f < 16; ++f) csv[f] = cs[f]; }
        asm volatile("" ::: "memory");
        if (idx + ngt < NTOK * 20) RP_FETCH(idx + ngt);
        float x1[16], x2[16];
#pragma unroll
        for (int q = 0; q < 2; ++q) { x1[8 * q] = bflo(w[q].x); x1[8 * q + 1] = bfhi(w[q].x); x1[8 * q + 2] = bflo(w[q].y); x1[8 * q + 3] = bfhi(w[q].y); x1[8 * q + 4] = bflo(w[q].z); x1[8 * q + 5] = bfhi(w[q].z); x1[8 * q + 6] = bflo(w[q].w); x1[8 * q + 7] = bfhi(w[q].w);
            x2[8 * q] = bflo(w[q + 2].x); x2[8 * q + 1] = bfhi(w[q + 2].x); x2[8 * q + 2] = bflo(w[q + 2].y); x2[8 * q + 3] = bfhi(w[q + 2].y); x2[8 * q + 4] = bflo(w[q + 2].z); x2[8 * q + 5] = bfhi(w[q + 2].z); x2[8 * q + 6] = bflo(w[q + 2].w); x2[8 * q + 7] = bfhi(w[q + 2].w); }
        const float sc = hh < 8 ? QSCALE : 1.f;
        if (m < NLAT) {
#pragma unroll
            for (int f = 0; f < 16; ++f) { const f32x2 c = csv[f]; const float o1 = x1[f] * c[0] - x2[f] * c[1], o2 = x2[f] * c[0] + x1[f] * c[1]; x1[f] = o1 * sc; x2[f] = o2 * sc; } }
        else {
#pragma unroll
            for (int f = 0; f < 16; ++f) { x1[f] *= sc; x2[f] *= sc; } }
        bf16_t* dst = hh < 8 ? QR + (size_t)m * 512 + hh * 64 + a * 32 : KR + (size_t)m * 128 + (hh - 8) * 64 + a * 32;
#pragma unroll
        for (int q = 0; q < 2; ++q) { u32x4 o; o.x = pk2(x1[8 * q], x1[8 * q + 1]); o.y = pk2(x1[8 * q + 2], x1[8 * q + 3]); o.z = pk2(x1[8 * q + 4], x1[8 * q + 5]); o.w = pk2(x1[8 * q + 6], x1[8 * q + 7]); ((u32x4*)dst)[q] = o;
            u32x4 o2; o2.x = pk2(x2[8 * q], x2[8 * q + 1]); o2.y = pk2(x2[8 * q + 2], x2[8 * q + 3]); o2.z = pk2(x2[8 * q + 4], x2[8 * q + 5]); o2.w = pk2(x2[8 * q + 6], x2[8 * q + 7]); ((u32x4*)dst)[q + 2] = o2; }
      } }
    { const float* cwm = p->in[I_MCONV] + (size_t)l * 3 * 512; bf16_t* MQB = WSP(bf16_t, WS_MQB); bf16_t* MKB = WSP(bf16_t, WS_MKB);
      u32x2 r0, r1, r2;
#define MF_FETCH(idx_) do { const int m_ = (idx_) >> 7, c_ = ((idx_) & 127) * 4; int pos_, len_; seq_info(m_, pos_, len_); const bf16_t* up_ = U + (size_t)m_ * INP + UC_ML + c_; \
        r1 = *(const u32x2*)up_; r0 = pos_ > 0 ? *(const u32x2*)(up_ - INP) : (u32x2){0u, 0u}; r2 = pos_ < len_ - 1 ? *(const u32x2*)(up_ + INP) : (u32x2){0u, 0u}; } while (0)
      if (gt < NTOK * 128) MF_FETCH(gt);
      const int c4h = (gt & 127) * 4;
      const f32x4 w0 = *(const f32x4*)(cwm + c4h), w1 = *(const f32x4*)(cwm + 512 + c4h), w2 = *(const f32x4*)(cwm + 1024 + c4h);
      for (int idx = gt; idx < NTOK * 128; idx += ngt) {
        const int m = idx >> 7, c4 = (idx & 127) * 4;
        const f32x4 x0 = (f32x4){bflo(r0.x), bfhi(r0.x), bflo(r0.y), bfhi(r0.y)}, x1 = (f32x4){bflo(r1.x), bfhi(r1.x), bflo(r1.y), bfhi(r1.y)}, x2 = (f32x4){bflo(r2.x), bfhi(r2.x), bflo(r2.y), bfhi(r2.y)};
        if (idx + ngt < NTOK * 128) MF_FETCH(idx + ngt);
        f32x4 y = x0 * w0 + x1 * w1 + x2 * w2;
#pragma unroll
        for (int i = 0; i < 4; ++i) y[i] = y[i] * sigm(y[i]);
        if (c4 < 256) st4bf(MQB + (size_t)m * 256 + c4, y); else st4bf(MKB + (size_t)m * 256 + c4 - 256, y * 0.125f);
      }
#undef MF_FETCH
    }
    {
      __syncthreads();
      { const int rot = (obid() * 7) % 224;
        for (int f = tid; f < 224 * 64; f += NTHR) { int row = (f >> 6) + rot; row = row >= 224 ? row - 224 : row; const int q = f & 63;
          const float* src = row < 64 ? p->in[I_RWUP] + (size_t)l * 64 * 256 + (size_t)row * 256 : row < 128 ? p->in[I_RAUP] + (size_t)l * 64 * 256 + (size_t)(row - 64) * 256 : row < 192 ? p->in[I_RGUP] + (size_t)l * 64 * 256 + (size_t)(row - 128) * 256 : p->in[I_RVUP] + (size_t)(row - 192) * 256;
          if (row < 192 || l == 1) { const f32x4 v = *(const f32x4*)(src + q * 4); u32x2 w; w.x = pk2(v[0], v[1]); w.y = pk2(v[2], v[3]); *(LAS u32x2*)(lds + row * 512 + q * 8) = w; } } }
      __syncthreads();
      LAS float* sx = (LAS float*)(lds + 114688) + wave * (4 * 224);
#define LORA_ROW(r_) ({ const u32x2 w_ = *(const LAS u32x2*)(lds + (r_) * 512 + c4 * 2); (f32x4){bflo(w_.x), bfhi(w_.x), bflo(w_.y), bfhi(w_.y)}; })
      const float* cw = p->in[I_RCONV] + (size_t)l * 3 * 960;
      const float* w0p = p->in[I_RW0] + l * 512; const float* wup = p->in[I_RWUP] + (size_t)l * 2 * 32 * 256;
      const float* a0p = p->in[I_RA0] + l * 512; const float* aup = p->in[I_RAUP] + (size_t)l * 2 * 32 * 256;
      const float* gup = p->in[I_RGUP] + (size_t)l * 64 * 256;
      const float* kkw = p->in[I_RKK] + l * 256; const float* kaw = p->in[I_RKA] + l * 256;
      const float* v0p = p->in[I_RV0]; const float* vup = p->in[I_RVUP];
      float* VF = WSP(float, WS_VF);
      const int c4 = lane * 4;
      u32x2 nraw[6][3]; bf16_t nxs[3][6]; bf16_t nhv[4];
#define RW_FETCH(grp_) do { const int m0_ = (grp_) * 4; int pos0_, len_; seq_info(m0_, pos0_, len_); const bool hp_ = pos0_ > 0, hn_ = pos0_ + 4 < len_; \
        _Pragma("unroll") for (int j = 0; j < 6; ++j) { const bool ok_ = (j == 0) ? hp_ : ((j == 5) ? hn_ : true); const bf16_t* rp_ = U + (size_t)(m0_ - 1 + j) * INP + UC_RW; \
            _Pragma("unroll") for (int g = 0; g < 3; ++g) { nraw[j][g] = ok_ ? *(const u32x2*)(rp_ + g * 256 + c4) : (u32x2){0u, 0u}; nxs[g][j] = ok_ ? rp_[768 + 64 * g + lane] : (bf16_t)0; } } \
        if (l == 1) { _Pragma("unroll") for (int tk = 0; tk < 4; ++tk) { nhv[tk] = lane < 32 ? U[(size_t)(m0_ + tk) * INP + UC_HV + lane] : (bf16_t)0; } } } while (0)
      if (gw < NTOK / 4) RW_FETCH(gw);
      for (int grp = gw; grp < NTOK / 4; grp += ngw) {
        const int m0 = grp * 4;
        f32x4 cv[4][3];
        { f32x4 raw[6][3];
#pragma unroll
          for (int j = 0; j < 6; ++j)
#pragma unroll
            for (int g = 0; g < 3; ++g) raw[j][g] = (f32x4){bflo(nraw[j][g].x), bfhi(nraw[j][g].x), bflo(nraw[j][g].y), bfhi(nraw[j][g].y)};
#pragma unroll
          for (int g = 0; g < 3; ++g) { const f32x4 k0 = *(const f32x4*)(cw + g * 256 + c4), k1 = *(const f32x4*)(cw + 960 + g * 256 + c4), k2 = *(const f32x4*)(cw + 1920 + g * 256 + c4);
#pragma unroll
            for (int tk = 0; tk < 4; ++tk) cv[tk][g] = raw[tk][g] * k0 + raw[tk + 1][g] * k1 + raw[tk + 2][g] * k2; } }
#pragma unroll
        for (int g = 0; g < 3; ++g) { const int col = 768 + 64 * g + lane; float x[6];
#pragma unroll
          for (int j = 0; j < 6; ++j) x[j] = bf2f(nxs[g][j]);
          const float k0 = cw[col], k1 = cw[960 + col], k2 = cw[1920 + col];
#pragma unroll
          for (int tk = 0; tk < 4; ++tk) { float val = x[tk] * k0 + x[tk + 1] * k1 + x[tk + 2] * k2; if (g == 0) val = 1.f - 2.f * __builtin_amdgcn_rcpf(1.f + __expf(2.f * val)); if (g == 2) val = sigm(val); sx[tk * 224 + g * 64 + lane] = val; } }
        if (l == 1 && lane < 32) {
#pragma unroll
          for (int tk = 0; tk < 4; ++tk) sx[tk * 224 + 192 + lane] = bf2f(nhv[tk]); }
        LDS_FENCE();
        const f32x4 kk_w = *(const f32x4*)(kkw + c4), ka_w = *(const f32x4*)(kaw + c4);
        f32x4 kkv[4];
#pragma unroll
        for (int tk = 0; tk < 4; ++tk) { const size_t o = (size_t)(m0 + tk) * 256 + c4;
          st4bf(RWB(RA_R) + o, cv[tk][0]);
          const f32x4 kkr = cv[tk][1] * kk_w; float ss = (kkr[0] * kkr[0] + kkr[1] * kkr[1]) + (kkr[2] * kkr[2] + kkr[3] * kkr[3]); ss = gsum16(ss);
          const float inv = 1.f / fmaxf(sqrtf(ss), 1e-12f);
          kkv[tk] = kkr * inv; st4bf(RWB(RA_KK) + o, kkv[tk]); }
        for (int d = 0; d < 2; ++d) {
          f32x4 acc[4];
#pragma unroll
          for (int tk = 0; tk < 4; ++tk) acc[tk] = *(const f32x4*)(w0p + d * 256 + c4);
#pragma unroll 4
          for (int j = 0; j < 32; ++j) { const f32x4 wr_ = LORA_ROW(d * 32 + j);
#pragma unroll
            for (int tk = 0; tk < 4; ++tk) acc[tk] += wr_ * sx[tk * 224 + d * 32 + j]; }
#pragma unroll
          for (int tk = 0; tk < 4; ++tk) { f32x4 lw;
#pragma unroll
            for (int i = 0; i < 4; ++i) lw[i] = -0.6065306597126334f * sigm(acc[tk][i]);
            *(f32x4*)(RWA(RA_LW0 + d) + (size_t)(m0 + tk) * 256 + c4) = lw; }
#pragma unroll
          for (int tk = 0; tk < 4; ++tk) acc[tk] = *(const f32x4*)(a0p + d * 256 + c4);
#pragma unroll 4
          for (int j = 0; j < 32; ++j) { const f32x4 ar_ = LORA_ROW(64 + d * 32 + j);
#pragma unroll
            for (int tk = 0; tk < 4; ++tk) acc[tk] += ar_ * sx[tk * 224 + 64 + d * 32 + j]; }
#pragma unroll
          for (int tk = 0; tk < 4; ++tk) { f32x4 a, kd;
#pragma unroll
            for (int i = 0; i < 4; ++i) { a[i] = sigm(acc[tk][i]); kd[i] = cv[tk][1][i] * (1.f + (a[i] - 1.f) * ka_w[i]); }
            st4bf(RWB(RA_A0 + d) + (size_t)(m0 + tk) * 256 + c4, a * kkv[tk]); st4bf(RWB(RA_KD0 + d) + (size_t)(m0 + tk) * 256 + c4, kd); }
        }
        asm volatile("" ::: "memory");
        if (grp + ngw < NTOK / 4) RW_FETCH(grp + ngw);
        { f32x4 acc[4];
#pragma unroll
          for (int tk = 0; tk < 4; ++tk) acc[tk] = (f32x4){0.f, 0.f, 0.f, 0.f};
#pragma unroll 4
          for (int j = 0; j < 64; ++j) { const f32x4 gr_ = LORA_ROW(128 + j);
#pragma unroll
            for (int tk = 0; tk < 4; ++tk) acc[tk] += gr_ * sx[tk * 224 + 128 + j]; }
#pragma unroll
          for (int tk = 0; tk < 4; ++tk) st4bf(RWB(RA_G) + (size_t)(m0 + tk) * 256 + c4, acc[tk]); }
        if (l == 0) {
#pragma unroll
          for (int tk = 0; tk < 4; ++tk) { const size_t o = (size_t)(m0 + tk) * 256 + c4; *(f32x4*)(VF + o) = cv[tk][2]; st4bf(RWB(RA_V) + o, cv[tk][2]); }
        } else { f32x4 acc[4];
#pragma unroll
          for (int tk = 0; tk < 4; ++tk) acc[tk] = *(const f32x4*)(v0p + c4);
#pragma unroll 4
          for (int j = 0; j < 32; ++j) { const f32x4 vr_ = LORA_ROW(192 + j);
#pragma unroll
            for (int tk = 0; tk < 4; ++tk) acc[tk] += vr_ * sx[tk * 224 + 192 + j]; }
#pragma unroll
          for (int tk = 0; tk < 4; ++tk) { const size_t o = (size_t)(m0 + tk) * 256 + c4; const f32x4 vf = *(const f32x4*)(VF + o); f32x4 v = cv[tk][2];
#pragma unroll
            for (int i = 0; i < 4; ++i) v[i] = v[i] + (vf[i] - v[i]) * sigm(acc[tk][i]);
            st4bf(RWB(RA_V) + o, v); } }
        LDS_FENCE();
      } }
}

template <int CTRL> __device__ __forceinline__ float dppf(float x) { return __int_as_float(__builtin_amdgcn_update_dpp(0, __float_as_int(x), CTRL, 0xF, 0xF, true)); }
__device__ __forceinline__ float red8(float x) { x += dppf<0xB1>(x); x += dppf<0x4E>(x); x += dppf<0x141>(x); return x; }
__device__ __forceinline__ int scan_row(int b, int d, int tau) {
    if (tau < LC) return NLAT + b * LC + (d ? LC - 1 - tau : tau);
    const int t = tau - LC; return b * T + (d ? T - 1 - t : t);
}
__device__ __forceinline__ int crow16(int r, int hi) { return (r & 3) + 8 * (r >> 2) + 4 * hi; }
constexpr int TP = 144, TSZ = 64 * TP;
constexpr int NCH = (LC + T) / 64;
constexpr int ML_T0 = 0, ML_T1 = TSZ, ML_T2 = 2 * TSZ, ML_T3 = 3 * TSZ, ML_T4 = 4 * TSZ, ML_AR = 5 * TSZ;
__device__ __forceinline__ f32x16 mm32(const LAS unsigned char* A, const LAS unsigned char* Bt, int r0, int c0, int r32, int hi, f32x16 acc) {
#pragma unroll
    for (int ks = 0; ks < 4; ++ks) { const bf16x8 a = *(const LAS bf16x8*)(A + (r0 + r32) * TP + ks * 32 + hi * 16), b = *(const LAS bf16x8*)(Bt + (c0 + r32) * TP + ks * 32 + hi * 16);
        acc = __builtin_amdgcn_mfma_f32_32x32x16_bf16(a, b, acc, 0, 0, 0); }
    return acc;
}
__device__ __forceinline__ f32x16 zero16() { f32x16 z;
#pragma unroll
    for (int r = 0; r < 16; ++r) z[r] = 0.f;
    return z; }
__device__ __forceinline__ float logsig(float v) { const float e = __expf(-fabsf(v)); return fminf(v, 0.f) - __logf(1.f + e); }
__device__ __forceinline__ void mlstm_phaseA(KPP p, int l, LAS unsigned char* lds) {
    const int tid = otid(), lane = tid & 63, wave = __builtin_amdgcn_readfirstlane(tid >> 6), half = wave >> 2, hw = wave & 3, htid = tid & 255, r32 = lane & 31, hi = lane >> 5;
    const bf16_t* U = WSP(bf16_t, WS_U); const bf16_t* MKB = WSP(bf16_t, WS_MKB); float* GT = WSP(float, WS_GT);
    float* DC = WSP(float, WS_MLDC); float* DN = WSP(float, WS_MLSM); float* GX = DN + 2 * 4224 * 64;
    const float* gb = p->in[I_MGB] + l * 16;
    LAS unsigned char* hb = lds + half * 24576; LAS float* sWK = (LAS float*)(hb + 2 * TSZ); LAS float* red = sWK + 64;
    const int G = gridDim.x;
#define MA_FETCH(itb_) do { const int it_ = 2 * (itb_) + half; const int ch_ = it_ / NCH, c_ = it_ % NCH, d_ = ch_ & 1, h_ = (ch_ >> 1) & 3, b_ = ch_ >> 3; \
        _Pragma("unroll") for (int r = 0; r < 2; ++r) { const int f_ = htid + 256 * r; const size_t m_ = (size_t)scan_row(b_, d_, 64 * c_ + (f_ >> 3)); \
            pk[r] = *(const u32x4*)(MKB + m_ * 256 + h_ * 64 + (f_ & 7) * 8); pv[r] = *(const u32x4*)(U + m_ * INP + UC_ML + 512 + h_ * 64 + (f_ & 7) * 8); } \
        if (hw == 0) { const size_t m_ = (size_t)scan_row(b_, d_, 64 * c_ + lane); gi = U[m_ * INP + UC_ML + 1024 + d_ * 8 + h_]; gf = U[m_ * INP + UC_ML + 1024 + d_ * 8 + 4 + h_]; } } while (0)
    u32x4 pk[2], pv[2]; bf16_t gi = 0, gf = 0;
    int itb = obid();
    if (itb < 16 * NCH) MA_FETCH(itb);
    while (itb < 16 * NCH) {
        const int item = 2 * itb + half; const int chain = item / NCH, c = item % NCH, d = chain & 1, h = (chain >> 1) & 3, b = chain >> 3;
        if (hw == 0) { const size_t m = (size_t)scan_row(b, d, 64 * c + lane);
            const float ig = bf2f(gi) + gb[d * 8 + h]; const float lf = logsig(bf2f(gf) + gb[d * 8 + 4 + h]);
            float bc = lf;
#pragma unroll
            for (int o = 1; o < 64; o <<= 1) { const float t = __shfl_up(bc, o); if (lane >= o) bc += t; }
            const float g = rlane(bc, 63);
            sWK[lane] = __expf(g - bc + ig); GT[m * 16 + d * 8 + h] = ig; GT[m * 16 + d * 8 + 4 + h] = bc;
            if (lane == 0) GX[item] = __expf(g); }
        __syncthreads();
        float pn[8];
#pragma unroll
        for (int e = 0; e < 8; ++e) pn[e] = 0.f;
#pragma unroll
        for (int r = 0; r < 2; ++r) { const int fpc = htid + 256 * r, srow = fpc >> 3, part = fpc & 7;
            const u32x4 kw = pk[r], vw = pv[r];
            const float wk = sWK[srow];
            const float kf[8] = {bflo(kw.x) * wk, bfhi(kw.x) * wk, bflo(kw.y) * wk, bfhi(kw.y) * wk, bflo(kw.z) * wk, bfhi(kw.z) * wk, bflo(kw.w) * wk, bfhi(kw.w) * wk};
            const unsigned vb[4] = {vw.x, vw.y, vw.z, vw.w};
#pragma unroll
            for (int e = 0; e < 8; ++e) { pn[e] += kf[e];
                *(LAS bf16_t*)(hb + TSZ + (part * 8 + e) * TP + srow * 2) = (bf16_t)f2bf(kf[e]);
                *(LAS bf16_t*)(hb + (part * 8 + e) * TP + srow * 2) = (bf16_t)((e & 1) ? (vb[e >> 1] >> 16) : (vb[e >> 1] & 0xffffu)); } }
#pragma unroll
        for (int e = 0; e < 8; ++e) { float v = pn[e]; v += __shfl_xor(v, 8); v += __shfl_xor(v, 16); v += __shfl_xor(v, 32); pn[e] = v; }
        if ((lane >> 3) == 0) {
#pragma unroll
            for (int e = 0; e < 8; ++e) red[hw * 64 + (lane & 7) * 8 + e] = pn[e]; }
        __syncthreads();
        const int nx = itb + G;
        if (nx < 16 * NCH) MA_FETCH(nx);
        { const int ti = hw & 1, tj = hw >> 1; const f32x16 acc = mm32(hb, hb + TSZ, 32 * ti, 32 * tj, r32, hi, zero16());
            float* dst = DC + (size_t)item * 4096 + 32 * tj + r32;
#pragma unroll
            for (int r = 0; r < 16; ++r) dst[(32 * ti + crow16(r, hi)) * 64] = acc[r];
            if (hw == 3) DN[(size_t)item * 64 + lane] = (red[lane] + red[64 + lane]) + (red[128 + lane] + red[192 + lane]); }
        __syncthreads();
        itb = nx;
    }
#undef MA_FETCH
}
__device__ __forceinline__ void mlstm_phaseB(KPP p, int chain) {
    const int tid = otid();
    const float* DC = WSP(float, WS_MLDC); const float* DN = WSP(float, WS_MLSM); float* NST = WSP(float, WS_MLSM) + 4224 * 64; const float* GX = DN + 2 * 4224 * 64; bf16_t* CS = WSP(bf16_t, WS_MLCS);
    f32x4 c0 = (f32x4){0.f, 0.f, 0.f, 0.f}, c1 = c0; float n = 0.f;
    f32x4 pa[4], pb[4]; float pg[4], pd[4];
#pragma unroll
    for (int q = 0; q < 4; ++q) { const size_t it = (size_t)chain * NCH + q; pa[q] = *(const f32x4*)(DC + it * 4096 + tid * 8); pb[q] = *(const f32x4*)(DC + it * 4096 + tid * 8 + 4); pg[q] = GX[it]; pd[q] = tid < 64 ? DN[it * 64 + tid] : 0.f; }
    for (int c4 = 0; c4 < NCH; c4 += 4) {
#pragma unroll
        for (int q = 0; q < 4; ++q) { const size_t it = (size_t)chain * NCH + c4 + q;
            u32x4 w; w.x = pk2(c0[0], c0[1]); w.y = pk2(c0[2], c0[3]); w.z = pk2(c1[0], c1[1]); w.w = pk2(c1[2], c1[3]); *(u32x4*)(CS + it * 4096 + tid * 8) = w;
            if (tid < 64) NST[it * 64 + tid] = n;
            c0 = c0 * pg[q] + pa[q]; c1 = c1 * pg[q] + pb[q]; n = n * pg[q] + pd[q];
            if (c4 + 4 + q < NCH) { const size_t nx = it + 4; pa[q] = *(const f32x4*)(DC + nx * 4096 + tid * 8); pb[q] = *(const f32x4*)(DC + nx * 4096 + tid * 8 + 4); pg[q] = GX[nx]; pd[q] = tid < 64 ? DN[nx * 64 + tid] : 0.f; } }
    }
}
constexpr int RL_AB = 0, RL_BT = TSZ, RL_KT = 2 * TSZ, RL_RB = 3 * TSZ, RL_BH = 4 * TSZ, RL_KH = 5 * TSZ, RL_VT = 6 * TSZ, RL_AK = 7 * TSZ, RL_ARB = 8 * TSZ, RL_ARK = 9 * TSZ;
constexpr int RL_WT = RL_AB, RL_UT = RL_BT;
constexpr int RL_AAB = 10 * TSZ, RL_XR = RL_AAB + 16384, XRP = 129, RL_RED = RL_XR + 64 * XRP * 4, RL_GL = RL_RED + 2048;
static_assert(RL_GL + 256 <= MISC_OFF, "rwkv phase A LDS");
__device__ __forceinline__ void rwkv_phaseA(KPP p, int l, LAS unsigned char* lds, int first, int stride) {
    const int tid = otid(), lane = tid & 63, wave = __builtin_amdgcn_readfirstlane(tid >> 6), col = lane, rg = wave, r32 = lane & 31, hi = lane >> 5;
    bf16_t* GH = WSP(bf16_t, WS_RGH); bf16_t* RWG = WSP(bf16_t, WS_RRW); bf16_t* YP = WSP(bf16_t, WS_RYP);
    LAS float* red = (LAS float*)(lds + RL_RED); LAS float* sGL = (LAS float*)(lds + RL_GL); LAS float* XR = (LAS float*)(lds + RL_XR); LAS float* AAB = (LAS float*)(lds + RL_AAB);
#define RA_FETCH(item_) do { const int ch_ = (item_) / NCH, c_ = (item_) % NCH, d_ = ch_ & 1, h_ = (ch_ >> 1) & 3, b_ = ch_ >> 3; \
        const long o0 = (long)scan_row(b_, d_, 64 * c_ + 8 * rg) * 256 + h_ * 64 + col; const int st = d_ ? -256 : 256; \
        const float* a0 = RWA(RA_LW0 + d_) + o0; const bf16_t* a1 = RWB(RA_A0 + d_) + o0; const bf16_t* a2 = RWB(RA_KD0 + d_) + o0; const bf16_t* a3 = RWB(RA_KK) + o0; const bf16_t* a4 = RWB(RA_R) + o0; const bf16_t* a5 = RWB(RA_V) + o0; \
        _Pragma("unroll") for (int i = 0; i < 8; ++i) { lw[i] = a0[i * st]; kab[i] = a1[i * st]; kdb[i] = a2[i * st]; kkb[i] = a3[i * st]; rrb[i] = a4[i * st]; vvb[i] = a5[i * st]; } } while (0)
    float lw[8]; bf16_t kab[8], kdb[8], kkb[8], rrb[8], vvb[8];
    int item = first;
    if (item < 32 * NCH) RA_FETCH(item);
    while (item < 32 * NCH) {
        const int chain = item / NCH, c = item % NCH, d = chain & 1, h = (chain >> 1) & 3, b = chain >> 3;
        float kk[8], ka[8], kd[8], rr[8], vv[8];
#pragma unroll
        for (int i = 0; i < 8; ++i) { ka[i] = bf2f(kab[i]); kd[i] = bf2f(kdb[i]); kk[i] = bf2f(kkb[i]); rr[i] = bf2f(rrb[i]); vv[i] = bf2f(vvb[i]); }
        asm volatile("" ::: "memory");
        float lwc[8];
#pragma unroll
        for (int i = 0; i < 8; ++i) lwc[i] = lw[i];
        float cum[8]; cum[0] = lwc[0];
#pragma unroll
        for (int i = 1; i < 8; ++i) cum[i] = cum[i - 1] + lwc[i];
        red[rg * 64 + col] = cum[7];
        __syncthreads();
        float off = 0.f, cL = 0.f;
#pragma unroll
        for (int g8 = 0; g8 < 8; ++g8) { const float t = red[g8 * 64 + col]; cL += t; off += g8 < rg ? t : 0.f; }
        float bhp[8], khp[8];
#pragma unroll
        for (int i = 0; i < 8; ++i) { const float ci = off + cum[i]; const float E = __expf(ci), Ei = __expf(-ci), Ep = __expf(ci - lwc[i]), EL = __expf(cL - ci);
            const int row = 8 * rg + i; const float ab = -kk[i] * Ep;
            *(LAS bf16_t*)(lds + RL_AB + row * TP + col * 2) = (bf16_t)f2bf(ab); *(LAS bf16_t*)(lds + RL_BT + row * TP + col * 2) = (bf16_t)f2bf(ka[i] * Ei);
            *(LAS bf16_t*)(lds + RL_KT + row * TP + col * 2) = (bf16_t)f2bf(kd[i] * Ei); *(LAS bf16_t*)(lds + RL_RB + row * TP + col * 2) = (bf16_t)f2bf(rr[i] * E);
            XR[row * XRP + col] = ab; bhp[i] = ka[i] * EL; khp[i] = kd[i] * EL; }
        { u32x4 w; w.x = pk2(bhp[0], bhp[1]); w.y = pk2(bhp[2], bhp[3]); w.z = pk2(bhp[4], bhp[5]); w.w = pk2(bhp[6], bhp[7]); *(LAS u32x4*)(lds + RL_BH + col * TP + rg * 16) = w;
          u32x4 y; y.x = pk2(khp[0], khp[1]); y.y = pk2(khp[2], khp[3]); y.z = pk2(khp[4], khp[5]); y.w = pk2(khp[6], khp[7]); *(LAS u32x4*)(lds + RL_KH + col * TP + rg * 16) = y;
          u32x4 z; z.x = pk2(vv[0], vv[1]); z.y = pk2(vv[2], vv[3]); z.z = pk2(vv[4], vv[5]); z.w = pk2(vv[6], vv[7]); *(LAS u32x4*)(lds + RL_VT + col * TP + rg * 16) = z; }
        if (rg == 0) sGL[col] = __expf(cL);
        __syncthreads();
        { const int pr = wave & 3; const LAS unsigned char* Aop = lds + (pr < 2 ? RL_AB : RL_RB); const LAS unsigned char* Bop = lds + ((pr & 1) ? RL_KT : RL_BT);
#pragma unroll
          for (int q = 0; q < 2; ++q) { const int ti = wave >> 2, tj = q; const bool zt = (ti == 0 && tj == 1);
            f32x16 acc = zero16(); if (!zt) acc = mm32(Aop, Bop, 32 * ti, 32 * tj, r32, hi, acc);
            const int sidx = 32 * tj + r32;
#pragma unroll
            for (int r = 0; r < 16; ++r) { const int t = 32 * ti + crow16(r, hi); const bool ok = pr < 2 ? (sidx < t) : (sidx <= t); const float v = (ok && !zt) ? acc[r] : 0.f;
                if (pr == 0) AAB[sidx * 64 + (t & 3) * 16 + (t >> 2)] = v;
                else *(LAS bf16_t*)(lds + (pr == 1 ? RL_AK : (pr == 2 ? RL_ARB : RL_ARK)) + t * TP + sidx * 2) = (bf16_t)f2bf(v); } } }
        __syncthreads();
        if (wave < 4) { const int ti = wave & 1, tj = wave >> 1; const f32x16 acc = mm32(lds + RL_AK, lds + RL_VT, 32 * ti, 32 * tj, r32, hi, zero16());
#pragma unroll
            for (int r = 0; r < 16; ++r) XR[(32 * ti + crow16(r, hi)) * XRP + 64 + 32 * tj + r32] = acc[r]; }
        __syncthreads();
        { const int cc = tid >> 2, ph = tid & 3; float x[16];
#pragma unroll
          for (int i = 0; i < 16; ++i) x[i] = XR[(4 * i + ph) * XRP + cc];
          asm volatile("" ::: "memory");
#define RW_SOLVE_STEP(S_) { constexpr int is_ = (S_) >> 2, ps_ = (S_) & 3; const float xs = dppf<ps_ * 0x55>(x[is_]); const LAS float* ap = AAB + (S_) * 64 + ph * 16; \
            _Pragma("unroll") for (int i4 = is_ >> 2; i4 < 4; ++i4) { const f32x4 a4 = *(const LAS f32x4*)(ap + 4 * i4); x[4 * i4] += a4[0] * xs; x[4 * i4 + 1] += a4[1] * xs; x[4 * i4 + 2] += a4[2] * xs; x[4 * i4 + 3] += a4[3] * xs; } }
#define RW_SOLVE4(S_) RW_SOLVE_STEP(S_) RW_SOLVE_STEP(S_ + 1) RW_SOLVE_STEP(S_ + 2) RW_SOLVE_STEP(S_ + 3) asm volatile("" ::: "memory");
#define RW_SOLVE16(S_) RW_SOLVE4(S_) RW_SOLVE4(S_ + 4) RW_SOLVE4(S_ + 8) RW_SOLVE4(S_ + 12)
          RW_SOLVE16(0) RW_SOLVE16(16) RW_SOLVE16(32) RW_SOLVE16(48)
#undef RW_SOLVE16
#undef RW_SOLVE4
#undef RW_SOLVE_STEP
          LAS unsigned char* tile = lds + (cc < 64 ? RL_WT : RL_UT) + (cc & 63) * TP;
#pragma unroll
          for (int i = 0; i < 16; ++i) *(LAS bf16_t*)(tile + (4 * i + ph) * 2) = (bf16_t)f2bf(x[i]); }
        __syncthreads();
        const int nitem = item + stride;
        if (nitem < 32 * NCH) RA_FETCH(nitem);
        { const int ti = wave & 1, tj = (wave >> 1) & 1; LAS float* stg = (LAS float*)(lds + RL_AAB);
          if (wave < 4) {
            f32x16 g = mm32(lds + RL_BH, lds + RL_WT, 32 * ti, 32 * tj, r32, hi, zero16());
            const int k = 32 * tj + r32; const float glk = sGL[k]; const int gb_ = ((k >> 4) * 64 + ((k >> 2) & 3) * 16) * 4 + (k & 3);
#pragma unroll
            for (int r = 0; r < 16; ++r) { const int kp = 32 * ti + crow16(r, hi); stg[gb_ + ((kp >> 4) * 256 + (kp & 15)) * 4] = g[r] + (kp == k ? glk : 0.f); }
            f32x16 w = mm32(lds + RL_ARB, lds + RL_WT, 32 * ti, 32 * tj, r32, hi, zero16());
#pragma unroll
            for (int r = 0; r < 16; ++r) { const int t = 32 * ti + crow16(r, hi); *(LAS bf16_t*)(lds + RL_AK + t * TP + k * 2) = (bf16_t)f2bf(w[r] + bf2f(*(const LAS bf16_t*)(lds + RL_RB + t * TP + k * 2))); }
          } else {
            f32x16 hh = mm32(lds + RL_KH, lds + RL_VT, 32 * ti, 32 * tj, r32, hi, zero16()); hh = mm32(lds + RL_BH, lds + RL_UT, 32 * ti, 32 * tj, r32, hi, hh);
            const int v = 32 * tj + r32; const int hb_ = 4096 + ((v >> 4) * 256 + (v & 15)) * 4;
#pragma unroll
            for (int r = 0; r < 16; ++r) { const int kp = 32 * ti + crow16(r, hi); stg[hb_ + ((kp >> 4) * 64 + ((kp >> 2) & 3) * 16) * 4 + (kp & 3)] = hh[r]; }
            f32x16 yy = mm32(lds + RL_ARK, lds + RL_VT, 32 * ti, 32 * tj, r32, hi, zero16()); yy = mm32(lds + RL_ARB, lds + RL_UT, 32 * ti, 32 * tj, r32, hi, yy);
            u32x4 w0, w1; w0.x = pk2(yy[0], yy[1]); w0.y = pk2(yy[2], yy[3]); w0.z = pk2(yy[4], yy[5]); w0.w = pk2(yy[6], yy[7]); w1.x = pk2(yy[8], yy[9]); w1.y = pk2(yy[10], yy[11]); w1.z = pk2(yy[12], yy[13]); w1.w = pk2(yy[14], yy[15]);
            u32x4* ypd = (u32x4*)(YP + (size_t)item * 4096 + ((wave & 3) * 64 + lane) * 16); ypd[0] = w0; ypd[1] = w1;
          } }
        __syncthreads();
        { const LAS f32x4* stg4 = (const LAS f32x4*)(lds + RL_AAB); u32x4* gdst = (u32x4*)(GH + (size_t)item * 8192);
#pragma unroll
          for (int r = 0; r < 2; ++r) { const f32x4 a = stg4[2 * (tid + 512 * r)], b = stg4[2 * (tid + 512 * r) + 1];
              u32x4 w; w.x = pk2(a[0], a[1]); w.y = pk2(a[2], a[3]); w.z = pk2(b[0], b[1]); w.w = pk2(b[2], b[3]); gdst[tid + 512 * r] = w; }
          *(u32x4*)(RWG + (size_t)item * 4096 + tid * 8) = *(const LAS u32x4*)(lds + RL_AK + (tid >> 3) * TP + (tid & 7) * 16); }
        __syncthreads();
        item = nitem;
    }
#undef RA_FETCH
}
#define RB_PUT(slot_, r_, w_) do { const u32x4 w__ = (w_); LAS unsigned char* d__ = (slot_) + (lt + 256 * (r_)) * 32; \
        *(LAS f32x4*)d__ = (f32x4){bflo(w__.x), bfhi(w__.x), bflo(w__.y), bfhi(w__.y)}; *(LAS f32x4*)(d__ + 16) = (f32x4){bflo(w__.z), bfhi(w__.z), bflo(w__.w), bfhi(w__.w)}; } while (0)
__device__ __forceinline__ void rwkv_phaseB(KPP p, int item, LAS unsigned char* lds) {
    const int chain = item >> 1, wgh = item & 1;
    const int tid = otid(), lane = tid & 63, wave = __builtin_amdgcn_readfirstlane(tid >> 6);
    const bf16_t* GH = WSP(bf16_t, WS_RGH) + (size_t)chain * NCH * 8192; bf16_t* SC = WSP(bf16_t, WS_RSC) + (size_t)chain * NCH * 4096;
    const bool loader = wave >= 4; const int lt = tid - 256;
    LAS float* xb = (LAS float*)(lds + 2 * 32768);
    f32x4 own[2], oth[2]; u32x4 pend[3][4];
    own[0] = own[1] = oth[0] = oth[1] = (f32x4){0.f, 0.f, 0.f, 0.f};
    if (loader) {
#pragma unroll
        for (int r = 0; r < 4; ++r) { const u32x4 w = *(const u32x4*)(GH + (lt + 256 * r) * 8); RB_PUT(lds, r, w); }
#pragma unroll
        for (int q = 0; q < 3; ++q)
#pragma unroll
            for (int r = 0; r < 4; ++r) pend[q][r] = *(const u32x4*)(GH + (size_t)(q + 1) * 8192 + (lt + 256 * r) * 8);
    }
    __syncthreads();
    for (int c3 = 0; c3 < NCH; c3 += 3) {
#pragma unroll
      for (int q = 0; q < 3; ++q) { const int c = c3 + q;
        if (loader) {
            if (c + 1 < NCH) {
#pragma unroll
                for (int r = 0; r < 4; ++r) RB_PUT(lds + ((c + 1) & 1) * 32768, r, pend[q][r]); }
            if (c + 4 < NCH) {
#pragma unroll
                for (int r = 0; r < 4; ++r) pend[q][r] = *(const u32x4*)(GH + (size_t)(c + 4) * 8192 + (lt + 256 * r) * 8); }
        } else {
            const int vs = 2 * wgh + (wave >> 1), mh = wave & 1, n = lane & 15, qq = lane >> 4;
            const LAS float* Gs = (const LAS float*)(lds + (c & 1) * 32768); const LAS float* Hs = Gs + 4096 + vs * 1024;
            if (c > 0) { const LAS float* xp = xb + ((c & 1) * 4 + (wave ^ 1)) * 512 + lane * 4; oth[0] = *(const LAS f32x4*)xp; oth[1] = *(const LAS f32x4*)(xp + 256); }
            bf16_t* sp = SC + (size_t)c * 4096 + (16 * vs + n) * 64 + 4 * qq + 32 * mh;
#pragma unroll
            for (int t2 = 0; t2 < 2; ++t2) { u32x2 w; w.x = pk2(own[t2][0], own[t2][1]); w.y = pk2(own[t2][2], own[t2][3]); *(u32x2*)(sp + 16 * t2) = w; }
            f32x4 old[4]; old[2 * mh] = own[0]; old[2 * mh + 1] = own[1]; old[2 * (mh ^ 1)] = oth[0]; old[2 * (mh ^ 1) + 1] = oth[1];
            f32x4 nacc[2];
#pragma unroll
            for (int t2 = 0; t2 < 2; ++t2) nacc[t2] = *(const LAS f32x4*)(Hs + ((2 * mh + t2) * 64 + lane) * 4);
#pragma unroll
            for (int sg = 0; sg < 4; ++sg) { f32x4 g4[2];
#pragma unroll
                for (int t2 = 0; t2 < 2; ++t2) g4[t2] = *(const LAS f32x4*)(Gs + (((2 * mh + t2) * 4 + sg) * 64 + lane) * 4);
#pragma unroll
                for (int si = 0; si < 4; ++si)
#pragma unroll
                    for (int t2 = 0; t2 < 2; ++t2) nacc[t2] = __builtin_amdgcn_mfma_f32_16x16x4f32(g4[t2][si], old[sg][si], nacc[t2], 0, 0, 0); }
            own[0] = nacc[0]; own[1] = nacc[1];
            { LAS float* xw = xb + (((c + 1) & 1) * 4 + wave) * 512 + lane * 4; *(LAS f32x4*)xw = own[0]; *(LAS f32x4*)(xw + 256) = own[1]; }
        }
        __syncthreads();
      }
    }
}
__device__ __forceinline__ f32x4 lo4(u32x4 w) { return (f32x4){bflo(w.x), bfhi(w.x), bflo(w.y), bfhi(w.y)}; }
__device__ __forceinline__ f32x4 hi4(u32x4 w) { return (f32x4){bflo(w.z), bfhi(w.z), bflo(w.w), bfhi(w.w)}; }
__device__ __forceinline__ float sum4(f32x4 a) { return (a[0] + a[1]) + (a[2] + a[3]); }
__device__ __forceinline__ void mixer_phaseC(KPP p, int l, LAS unsigned char* lds) {
    const int tid = otid(), lane = tid & 63, wave = __builtin_amdgcn_readfirstlane(tid >> 6), half = wave >> 2, hw = wave & 3, htid = tid & 255, r32 = lane & 31, hi = lane >> 5;
    const bf16_t* U = WSP(bf16_t, WS_U); const bf16_t* MQB = WSP(bf16_t, WS_MQB); const bf16_t* MKB = WSP(bf16_t, WS_MKB); const float* GT = WSP(float, WS_GT);
    const float* NST = WSP(float, WS_MLSM) + 4224 * 64; const bf16_t* CS = WSP(bf16_t, WS_MLCS);
    const bf16_t* RWG = WSP(bf16_t, WS_RRW); const bf16_t* YP = WSP(bf16_t, WS_RYP); const bf16_t* SC = WSP(bf16_t, WS_RSC); bf16_t* MIX = WSP(bf16_t, WS_MIX);
    LAS unsigned char* hb = lds + half * 49152;
    LAS float* sBC = (LAS float*)(hb + 5 * TSZ); LAS float* sA = sBC + 64; LAS bf16_t* sN = (LAS bf16_t*)(sBC + 128);
    LAS bf16_t* ORW = (LAS bf16_t*)(lds + 98304); LAS bf16_t* OML = ORW + 2 * 4096;
    const int G = gridDim.x, d = half;
#define MX_ITEM(pidx_) ((((pidx_) / NCH) * 2 + d) * NCH + (d == 0 ? (pidx_) % NCH : (((pidx_) % NCH) < 4 ? 3 - ((pidx_) % NCH) : 135 - ((pidx_) % NCH))))
#define MX_SKIP(pidx_) (l == 1 && ((pidx_) % NCH) < 4)
#define MX_FETCH_RW(pidx_) do { const size_t it0_ = (size_t)MX_ITEM(pidx_) * 4096; \
        _Pragma("unroll") for (int r = 0; r < 2; ++r) { tr[r] = *(const u32x4*)(RWG + it0_ + (htid + 256 * r) * 8); ts[r] = *(const u32x4*)(SC + it0_ + (htid + 256 * r) * 8); ty[r] = *(const u32x4*)(YP + it0_ + htid * 16 + 8 * r); } } while (0)
#define MX_FETCH_ML(pidx_) do { const int it_ = MX_ITEM(pidx_); const int c_ = it_ % NCH, bh_ = (pidx_) / NCH, h_ = bh_ & 3, b_ = bh_ >> 2; \
        _Pragma("unroll") for (int r = 0; r < 2; ++r) { const int f_ = htid + 256 * r; const size_t m_ = (size_t)scan_row(b_, d, 64 * c_ + (f_ >> 3)); \
            pq[r] = *(const u32x4*)(MQB + m_ * 256 + h_ * 64 + (f_ & 7) * 8); pk[r] = *(const u32x4*)(MKB + m_ * 256 + h_ * 64 + (f_ & 7) * 8); \
            pv[r] = *(const u32x4*)(U + m_ * INP + UC_ML + 512 + h_ * 64 + (f_ & 7) * 8); pc[r] = *(const u32x4*)(CS + (size_t)it_ * 4096 + f_ * 8); } \
        if (hw == 0) { const size_t m_ = (size_t)scan_row(b_, d, 64 * c_ + lane); gi = GT[m_ * 16 + d * 8 + h_]; gb_ = GT[m_ * 16 + d * 8 + 4 + h_]; gn = NST[(size_t)it_ * 64 + lane]; } } while (0)
    int pidx = obid(); while (pidx < 16 * NCH && MX_SKIP(pidx)) pidx += G;
    u32x4 tr[2], ts[2], ty[2], pq[2], pk[2], pv[2], pc[2]; float gi = 0.f, gb_ = 0.f, gn = 0.f;
    if (pidx < 16 * NCH) { MX_FETCH_RW(pidx); MX_FETCH_ML(pidx); }
    const int ti = hw & 1, tj = hw >> 1, vcol = 32 * tj + r32;
    while (pidx < 16 * NCH) {
        const int item = MX_ITEM(pidx); const int bh = pidx / NCH, j = pidx % NCH, h = bh & 3, b = bh >> 2;
#pragma unroll
        for (int r = 0; r < 2; ++r) { const int f = htid + 256 * r; *(LAS u32x4*)(hb + (f >> 3) * TP + (f & 7) * 16) = tr[r]; *(LAS u32x4*)(hb + TSZ + (f >> 3) * TP + (f & 7) * 16) = ts[r]; }
        const float ypv[16] = {bflo(ty[0].x), bfhi(ty[0].x), bflo(ty[0].y), bfhi(ty[0].y), bflo(ty[0].z), bfhi(ty[0].z), bflo(ty[0].w), bfhi(ty[0].w),
                               bflo(ty[1].x), bfhi(ty[1].x), bflo(ty[1].y), bfhi(ty[1].y), bflo(ty[1].z), bfhi(ty[1].z), bflo(ty[1].w), bfhi(ty[1].w)};
        __syncthreads();
        int nx = pidx + G; while (nx < 16 * NCH && MX_SKIP(nx)) nx += G;
        if (nx < 16 * NCH) MX_FETCH_RW(nx);
        { const f32x16 acc = mm32(hb, hb + TSZ, 32 * ti, 32 * tj, r32, hi, zero16());
#pragma unroll
          for (int r = 0; r < 16; ++r) ORW[d * 4096 + (32 * ti + crow16(r, hi)) * 64 + vcol] = (bf16_t)f2bf(acc[r] + ypv[r]); }
        __syncthreads();
        if (hw == 0) { sBC[lane] = gb_; sA[lane] = gi - gb_; sN[lane] = (bf16_t)f2bf(gn); }
#pragma unroll
        for (int r = 0; r < 2; ++r) { const int f = htid + 256 * r, row = f >> 3, part = f & 7;
            *(LAS u32x4*)(hb + row * TP + part * 16) = pq[r]; *(LAS u32x4*)(hb + TSZ + row * TP + part * 16) = pk[r]; *(LAS u32x4*)(hb + 3 * TSZ + row * TP + part * 16) = pc[r];
            const unsigned vb[4] = {pv[r].x, pv[r].y, pv[r].z, pv[r].w};
#pragma unroll
            for (int e = 0; e < 8; ++e) *(LAS bf16_t*)(hb + 2 * TSZ + (part * 8 + e) * TP + row * 2) = (bf16_t)((e & 1) ? (vb[e >> 1] >> 16) : (vb[e >> 1] & 0xffffu)); }
        __syncthreads();
        if (nx < 16 * NCH) MX_FETCH_ML(nx);
        { const f32x16 sacc = mm32(hb, hb + TSZ, 32 * ti, 32 * tj, r32, hi, zero16());
            const int sidx = 32 * tj + r32; const float as = sA[sidx];
#pragma unroll
            for (int r = 0; r < 16; ++r) { const int t = 32 * ti + crow16(r, hi); const float v = sidx <= t ? sacc[r] * __expf(sBC[t] + as) : 0.f; *(LAS bf16_t*)(hb + 4 * TSZ + t * TP + sidx * 2) = (bf16_t)f2bf(v); } }
        __syncthreads();
        {   const f32x16 n1 = mm32(hb + 4 * TSZ, hb + 2 * TSZ, 32 * ti, 32 * tj, r32, hi, zero16());
            const f32x16 n2 = mm32(hb, hb + 3 * TSZ, 32 * ti, 32 * tj, r32, hi, zero16());
            f32x16 d1 = zero16(), d2 = zero16(); const bf16x8 ones = (bf16x8){0x3F80, 0x3F80, 0x3F80, 0x3F80, 0x3F80, 0x3F80, 0x3F80, 0x3F80};
#pragma unroll
            for (int ks = 0; ks < 4; ++ks) { const bf16x8 a1 = *(const LAS bf16x8*)(hb + 4 * TSZ + (32 * ti + r32) * TP + ks * 32 + hi * 16), a2 = *(const LAS bf16x8*)(hb + (32 * ti + r32) * TP + ks * 32 + hi * 16);
                const bf16x8 nb = *(const LAS bf16x8*)((const LAS unsigned char*)sN + ks * 32 + hi * 16);
                d1 = __builtin_amdgcn_mfma_f32_32x32x16_bf16(a1, ones, d1, 0, 0, 0); d2 = __builtin_amdgcn_mfma_f32_32x32x16_bf16(a2, nb, d2, 0, 0, 0); }
#pragma unroll
            for (int r = 0; r < 16; ++r) { const int t = 32 * ti + crow16(r, hi); const float eb = __expf(sBC[t]);
                const float num = n1[r] + eb * n2[r], den = d1[r] + eb * d2[r];
                OML[d * 4096 + t * 64 + vcol] = (bf16_t)f2bf(num * __builtin_amdgcn_rcpf(fmaxf(fabsf(den), 1.f))); } }
        __syncthreads();
        { const int t = tid >> 3, c8 = (tid & 7) * 8; const size_t m = (size_t)(j < 4 ? NLAT + b * LC + 64 * j : b * T + 64 * (j - 4)) + t; const int ch = h * 64 + c8;
          float eps_rw = 64e-5f, eps_ml = 1e-5f; asm volatile("" : "+v"(eps_rw), "+v"(eps_ml));
          const u32x4 wr = *(const u32x4*)(RWB(RA_R) + m * 256 + ch), wv = *(const u32x4*)(RWB(RA_V) + m * 256 + ch), wg = *(const u32x4*)(RWB(RA_G) + m * 256 + ch);
          const u32x4 wk0 = *(const u32x4*)(RWB(RA_KD0) + m * 256 + ch), wk1 = *(const u32x4*)(RWB(RA_KD0 + 1) + m * 256 + ch), wo = *(const u32x4*)(U + m * INP + UC_ML + 768 + ch);
          const float* cst = p->in[I_RRK] + l * 256 + ch; const f32x4 rka = *(const f32x4*)cst, rkb = *(const f32x4*)(cst + 4);
          const float* cw_ = p->in[I_RLNW] + l * 256 + ch; const f32x4 lwa = *(const f32x4*)cw_, lwb = *(const f32x4*)(cw_ + 4);
          const float* cb_ = p->in[I_RLNB] + l * 256 + ch; const f32x4 lba = *(const f32x4*)cb_, lbb = *(const f32x4*)(cb_ + 4);
          const float* cm_ = p->in[I_MLNW] + l * 256 + ch; const f32x4 mwa = *(const f32x4*)cm_, mwb = *(const f32x4*)(cm_ + 4);
          const f32x4 ra = lo4(wr), rb = hi4(wr), va = lo4(wv), vb2 = hi4(wv);
          f32x4 acca = (f32x4){0.f, 0.f, 0.f, 0.f}, accb = acca;
#pragma unroll
          for (int dd = 0; dd < 2; ++dd) { const u32x4 wy = *(const LAS u32x4*)(ORW + dd * 4096 + (dd ? 63 - t : t) * 64 + c8); const u32x4 wkd = dd ? wk1 : wk0;
              const f32x4 ya = lo4(wy), yb = hi4(wy), ka = lo4(wkd), kb = hi4(wkd);
              const float mu = red8(sum4(ya) + sum4(yb)) * (1.f / 64.f); const f32x4 ca = ya - mu, cb = yb - mu;
              const float var = red8(sum4(ca * ca) + sum4(cb * cb)) * (1.f / 64.f); const float rs = rsqrtf(var + eps_rw);
              const float bs = red8(sum4(ra * ka * rka) + sum4(rb * kb * rkb));
              acca += ca * rs * lwa + lba + va * bs; accb += cb * rs * lwb + lbb + vb2 * bs; }
          { const f32x4 oa = acca * lo4(wg), ob = accb * hi4(wg); u32x4 w; w.x = pk2(oa[0], oa[1]); w.y = pk2(oa[2], oa[3]); w.z = pk2(ob[0], ob[1]); w.w = pk2(ob[2], ob[3]);
            *(u32x4*)(MIX + m * 1024 + 512 + ch) = w; }
          const u32x4 h0 = *(const LAS u32x4*)(OML + t * 64 + c8), h1 = *(const LAS u32x4*)(OML + 4096 + (63 - t) * 64 + c8);
          const f32x4 ha = lo4(h0) + lo4(h1), hbv = hi4(h0) + hi4(h1);
          const float mu = red8(sum4(ha) + sum4(hbv)) * (1.f / 64.f); const f32x4 ca = ha - mu, cb = hbv - mu;
          const float var = red8(sum4(ca * ca) + sum4(cb * cb)) * (1.f / 64.f); const float rs = rsqrtf(var + eps_ml);
          const f32x4 oga = lo4(wo), ogb = hi4(wo); f32x4 oa, ob;
#pragma unroll
          for (int i = 0; i < 4; ++i) { oa[i] = ca[i] * rs * mwa[i] * sigm(oga[i]); ob[i] = cb[i] * rs * mwb[i] * sigm(ogb[i]); }
          u32x4 w; w.x = pk2(oa[0], oa[1]); w.y = pk2(oa[2], oa[3]); w.z = pk2(ob[0], ob[1]); w.w = pk2(ob[2], ob[3]);
          *(u32x4*)(MIX + m * 1024 + 768 + ch) = w; }
        pidx = nx;
    }
#undef MX_ITEM
#undef MX_SKIP
#undef MX_FETCH_RW
#undef MX_FETCH_ML
}

__device__ __forceinline__ s16x4 vtr(const LAS unsigned char* ptr) { typedef short v4i16_t __attribute__((ext_vector_type(4))); return __builtin_bit_cast(s16x4, __builtin_amdgcn_ds_read_tr16_b64_v4i16((LAS v4i16_t*)ptr)); }
constexpr int AT_PITCH = 144, AT_TILE = 64 * AT_PITCH;
__device__ __forceinline__ void attn_unit(KPP p, int l, int unit, LAS unsigned char* lds) {
    const int tid = otid(), lane = tid & 63, wave = __builtin_amdgcn_readfirstlane(tid >> 6), r32 = lane & 31, hi = lane >> 5;
    const bf16_t* QR = WSP(bf16_t, WS_QR); const bf16_t* KR = WSP(bf16_t, WS_KR); const bf16_t* U = WSP(bf16_t, WS_U); bf16_t* MIX = WSP(bf16_t, WS_MIX);
    int b, kvh, t0, nl, i_lo; bool isctx;
    if (unit < 1024) { b = unit >> 8; kvh = (unit >> 7) & 1; t0 = (unit & 127) * 64; isctx = false;
        i_lo = t0 >= 128 ? 0 : (t0 >= 64 ? 1 : 2); const int i_hi = (t0 + 192 <= T) ? 4 : ((t0 + 128 <= T) ? 3 : 2); nl = i_hi - i_lo + 1; }
    else { const int u2 = unit - 1024; b = u2 >> 3; kvh = (u2 >> 2) & 1; t0 = (u2 & 3) * 64; isctx = true; nl = 0; i_lo = 0; }
    const int nt = nl + 4;
    const int hq = kvh * 4 + (wave >> 1), qoff = 32 * (wave & 1);
    const size_t qrow = (size_t)(isctx ? NLAT + b * LC : b * T) + t0 + qoff + r32;
    bf16x8 qf[4];
#pragma unroll
    for (int ds = 0; ds < 4; ++ds) qf[ds] = *(const bf16x8*)(QR + qrow * 512 + hq * 64 + 16 * ds + 8 * hi);
    const float sinkv = p->in[I_SINK][l * 8 + hq] * 1.4426950408889634f;
    float mrun = sinkv, lrun = hi == 0 ? 1.f : 0.f;
    f32x16 o[2];
#pragma unroll
    for (int r = 0; r < 16; ++r) { o[0][r] = 0.f; o[1][r] = 0.f; }
    const int skey = tid >> 3, spart = tid & 7;
    u32x4 kreg, vreg, kreg2, vreg2;
#define AT_ROWBASE(j) ((j) < nl ? b * T + t0 - 128 + 64 * (i_lo + (j)) : NLAT + b * LC + 64 * ((j) - nl))
#define AT_LOAD(KR_, VR_, j) do { const size_t rw = (size_t)(AT_ROWBASE(j) + skey); KR_ = *(const u32x4*)(KR + rw * 128 + kvh * 64 + spart * 8); VR_ = *(const u32x4*)(U + rw * INP + UC_V + kvh * 64 + spart * 8); } while (0)
#define AT_STORE(KR_, VR_, buf) do { *(LAS u32x4*)(lds + (buf) * AT_TILE + skey * AT_PITCH + spart * 16) = KR_; *(LAS u32x4*)(lds + 2 * AT_TILE + (buf) * AT_TILE + skey * AT_PITCH + spart * 16) = VR_; } while (0)
    AT_LOAD(kreg, vreg, 0); AT_STORE(kreg, vreg, 0); AT_LOAD(kreg, vreg, 1); __syncthreads();
    for (int j = 0; j < nt; ++j) {
        if (j + 2 < nt) AT_LOAD(kreg2, vreg2, j + 2);
        const LAS unsigned char* Kb = lds + (j & 1) * AT_TILE; const LAS unsigned char* Vb = lds + 2 * AT_TILE + (j & 1) * AT_TILE;
        f32x16 p0, p1;
#pragma unroll
        for (int r = 0; r < 16; ++r) { p0[r] = 0.f; p1[r] = 0.f; }
#pragma unroll
        for (int ds = 0; ds < 4; ++ds) {
            const bf16x8 a0 = *(const LAS bf16x8*)(Kb + r32 * AT_PITCH + ds * 32 + hi * 16), a1 = *(const LAS bf16x8*)(Kb + (32 + r32) * AT_PITCH + ds * 32 + hi * 16);
            p0 = __builtin_amdgcn_mfma_f32_32x32x16_bf16(a0, qf[ds], p0, 0, 0, 0); p1 = __builtin_amdgcn_mfma_f32_32x32x16_bf16(a1, qf[ds], p1, 0, 0, 0); }
        const int mtype = (j < nl) ? ((i_lo + j) == 0 ? 1 : ((i_lo + j) == 4 ? 2 : 0)) : 0;
        if (mtype != 0) { const int x = qoff + r32;
#pragma unroll
            for (int r = 0; r < 16; ++r) { const int k0 = crow16(r, hi), k1 = k0 + 32;
                const bool ok0 = mtype == 1 ? (k0 >= x) : (k0 <= x), ok1 = mtype == 1 ? (k1 >= x) : (k1 <= x);
                p0[r] = ok0 ? p0[r] : -INFINITY; p1[r] = ok1 ? p1[r] : -INFINITY; } }
        float mt = fmaxf(p0[0], p1[0]);
#pragma unroll
        for (int r = 1; r < 16; ++r) mt = fmaxf(mt, fmaxf(p0[r], p1[r]));
        mt = fmaxf(mt, __shfl_xor(mt, 32));
        const float mnew = fmaxf(mrun, mt), alpha = __builtin_amdgcn_exp2f(mrun - mnew); mrun = mnew;
        float rs = 0.f;
#pragma unroll
        for (int r = 0; r < 16; ++r) { p0[r] = __builtin_amdgcn_exp2f(p0[r] - mnew); p1[r] = __builtin_amdgcn_exp2f(p1[r] - mnew); rs += p0[r] + p1[r]; }
        lrun = lrun * alpha + rs;
#pragma unroll
        for (int r = 0; r < 16; ++r) { o[0][r] *= alpha; o[1][r] *= alpha; }
        bf16x8 pb[4];
#pragma unroll
        for (int s = 0; s < 2; ++s) {
            u32x4 w0, w1;
            w0.x = pk2(p0[8 * s], p0[8 * s + 1]); w0.y = pk2(p0[8 * s + 2], p0[8 * s + 3]); w0.z = pk2(p0[8 * s + 4], p0[8 * s + 5]); w0.w = pk2(p0[8 * s + 6], p0[8 * s + 7]);
            w1.x = pk2(p1[8 * s], p1[8 * s + 1]); w1.y = pk2(p1[8 * s + 2], p1[8 * s + 3]); w1.z = pk2(p1[8 * s + 4], p1[8 * s + 5]); w1.w = pk2(p1[8 * s + 6], p1[8 * s + 7]);
            pb[s] = __builtin_bit_cast(bf16x8, w0); pb[2 + s] = __builtin_bit_cast(bf16x8, w1); }
#pragma unroll
        for (int dblk = 0; dblk < 2; ++dblk)
#pragma unroll
            for (int ks = 0; ks < 4; ++ks) {
                const LAS unsigned char* vp = Vb + (16 * ks + 4 * hi + ((lane & 15) >> 2)) * AT_PITCH + (32 * dblk + 16 * ((lane >> 4) & 1) + 4 * (lane & 3)) * 2;
                const s16x4 t1 = vtr(vp), t2 = vtr(vp + 8 * AT_PITCH);
                const bf16x8 av = (bf16x8){t1[0], t1[1], t1[2], t1[3], t2[0], t2[1], t2[2], t2[3]};
                o[dblk] = __builtin_amdgcn_mfma_f32_32x32x16_bf16(av, pb[ks], o[dblk], 0, 0, 0); }
        if (j + 1 < nt) AT_STORE(kreg, vreg, (j + 1) & 1);
        kreg = kreg2; vreg = vreg2;
        __syncthreads();
    }
#undef AT_ROWBASE
#undef AT_LOAD
#undef AT_STORE
    const float inv = 1.f / (lrun + __shfl_xor(lrun, 32));
#pragma unroll
    for (int dblk = 0; dblk < 2; ++dblk)
#pragma unroll
        for (int g4 = 0; g4 < 4; ++g4) { const int d = 32 * dblk + 8 * g4 + 4 * hi;
            u32x2 w; w.x = pk2(o[dblk][4 * g4] * inv, o[dblk][4 * g4 + 1] * inv); w.y = pk2(o[dblk][4 * g4 + 2] * inv, o[dblk][4 * g4 + 3] * inv);
            *(u32x2*)(MIX + qrow * 1024 + hq * 64 + d) = w; }
}
__device__ __forceinline__ void phase_scan_attn(KPP p, int l, LAS unsigned char* lds) {
    const int tid = otid(), bid = obid();
    if (bid < 64) rwkv_phaseB(p, bid, lds);
    else if (bid < 96) { mlstm_phaseB(p, bid - 64); __syncthreads(); }
    unsigned* ctr = WSP(unsigned, WS_CTL) + CW_ATT + l * 64;
    volatile LAS int* misc = (volatile LAS int*)(lds + MISC_OFF);
    const int nunits = 1024 + (l == 0 ? 32 : 0);
    { if (tid == 0) misc[0] = (int)atomicAdd(ctr, 1u); __syncthreads(); int unit = misc[0]; __syncthreads();
      while (unit < nunits) { int pend = 0; if (tid == 0) pend = (int)atomicAdd(ctr, 1u);
          attn_unit(p, l, unit, lds);
          if (tid == 0) misc[0] = pend; __syncthreads(); unit = misc[0]; __syncthreads(); } }
    {
      const int wave = tid >> 6, lane = tid & 63; LAS float* scr = (LAS float*)(lds + 16384) + wave * (64 * 33);
      unsigned* wctr = WSP(unsigned, WS_CTL) + CW_ATT + l * 64 + 16; const int nit = l == 0 ? WC_N1 : WC_N2;
      for (;;) { int b0 = 0; if (lane == 0) b0 = (int)atomicAdd(wctr, 16u); b0 = __builtin_amdgcn_readfirstlane(b0); if (b0 >= nit) break;
        const int b1 = b0 + 16 < nit ? b0 + 16 : nit;
        for (int it = b0; it < b1; ++it) weight_copy_item(p, l + 1, it, scr, lane); } }
}

__device__ __forceinline__ void phase_router(KPP p, int l, LAS unsigned char* lds) {
    const int tid = otid(), lane = tid & 63, wave = tid >> 6, gw = obid() * NWAVES + wave, ngw = gridDim.x * NWAVES;
    const int mhi = l == 0 ? NTOK : NLAT;
    const float* g = p->in[I_N2G] + l * 1024; const float* MOD = WSP(float, WS_MOD) + (size_t)l * 5 * 6144;
    const unsigned* X = WSP(unsigned, WS_X); unsigned* H = WSP(unsigned, WS_H);
    const float* RW = p->in[I_ROUTW] + (size_t)l * 1024 * 32; const float* RB = p->in[I_ROUTB] + l * 32;
    unsigned* cnt = WSP(unsigned, WS_CTL) + CW_CNT + l * 2048; int* list = WSP(int, WS_LIST); float* gl = WSP(float, WS_GL);
    LAS unsigned* lcnt = (LAS unsigned*)(lds + 131072); LAS unsigned* lbase = lcnt + 32; LAS unsigned* lnent = lcnt + 64; LAS unsigned* lent = lcnt + 128;
    if (tid < 32) lcnt[tid] = 0u; if (tid == 32) *lnent = 0u;
    { const int rot = (obid() * 37) & 1023;
      for (int f0 = tid; f0 < 8192; f0 += NTHR) { const int f = (f0 + rot * 8) & 8191; const int k0 = f >> 3, c = f & 7, k = ((k0 & 127) >> 1) + 64 * (2 * (k0 >> 7) + (k0 & 1));
          *(LAS f32x4*)(lds + k * 128 + ((c ^ ((k >> 1) & 7)) << 4)) = *(const f32x4*)(RW + (size_t)f * 4); } }
    __syncthreads();
    unsigned nx0[8], nx1[8];
    if (gw < mhi / 2) { const unsigned* q0 = X + (size_t)(gw * 2) * (D / 2) + lane;
#pragma unroll
        for (int j = 0; j < 8; ++j) { nx0[j] = q0[64 * j]; nx1[j] = q0[D / 2 + 64 * j]; } }
    f32x2 gk[8];
#pragma unroll
    for (int j = 0; j < 8; ++j) gk[j] = *(const f32x2*)(g + 2 * lane + 128 * j);
    const float rbias = RB[lane & 31];
    for (int pi = gw; pi < mhi / 2; pi += ngw) {
        const int m0 = pi * 2; const int mr = m0 < NLAT ? (m0 >> 13) : 4; const float* shift = MOD + mr * 6144 + 3 * 1024; const float* scale = MOD + mr * 6144 + 4 * 1024;
        unsigned* hp0 = H + (size_t)m0 * (D / 2) + lane; unsigned* hp1 = hp0 + D / 2;
        const float* scp = scale + 2 * lane; const float* shp = shift + 2 * lane;
        f32x2 scv[8], shv[8];
#pragma unroll
        for (int j = 0; j < 8; ++j) { scv[j] = *(const f32x2*)(scp + 128 * j); shv[j] = *(const f32x2*)(shp + 128 * j); }
        asm volatile("" ::: "memory");
        float x0[16], x1[16]; float s0 = 0.f, s1 = 0.f;
#pragma unroll
        for (int j = 0; j < 8; ++j) { x0[2 * j] = bflo(nx0[j]); x0[2 * j + 1] = bfhi(nx0[j]); x1[2 * j] = bflo(nx1[j]); x1[2 * j + 1] = bfhi(nx1[j]); }
#pragma unroll
        for (int jj = 0; jj < 16; ++jj) { s0 += x0[jj] * x0[jj]; s1 += x1[jj] * x1[jj]; }
        if (pi + ngw < mhi / 2) { const unsigned* q0 = X + (size_t)((pi + ngw) * 2) * (D / 2) + lane;
#pragma unroll
            for (int j = 0; j < 8; ++j) { nx0[j] = q0[64 * j]; nx1[j] = q0[D / 2 + 64 * j]; } }
        const float r0 = rsqrtf(wsum(s0) * (1.f / 1024.f) + 1e-6f), r1 = rsqrtf(wsum(s1) * (1.f / 1024.f) + 1e-6f);
        float v[64];
#pragma unroll
        for (int e = 0; e < 64; ++e) v[e] = 0.f;
        const LAS unsigned char* wbase = lds + lane * 128; const int sw = (lane >> 1) & 7;
#pragma unroll
        for (int j = 0; j < 8; ++j) { const f32x2 sc2 = scv[j], sh2 = shv[j], g2 = gk[j];
            float hh0[2], hh1[2];
#pragma unroll
            for (int i2 = 0; i2 < 2; ++i2) { const int jj = 2 * j + i2; const float sc = sc2[i2] + 1.f, sh = sh2[i2], gkk = g2[i2];
                const float h0 = (x0[jj] * r0 * gkk) * sc + sh, h1 = (x1[jj] * r1 * gkk) * sc + sh; hh0[i2] = h0; hh1[i2] = h1;
#pragma unroll
                for (int q = 0; q < 8; ++q) { const f32x4 w4 = *(const LAS f32x4*)(wbase + jj * 8192 + ((q ^ sw) << 4));
#pragma unroll
                    for (int i = 0; i < 4; ++i) { v[4 * q + i] += h0 * w4[i]; v[32 + 4 * q + i] += h1 * w4[i]; } } }
            hp0[64 * j] = pk2(hh0[0], hh0[1]); hp1[64 * j] = pk2(hh1[0], hh1[1]);
            if ((j & 3) == 3) asm volatile("" ::: "memory"); }
#pragma unroll
        for (int o = 32; o >= 1; o >>= 1) { const bool up = (lane & o) != 0;
#pragma unroll
            for (int i = 0; i < o; ++i) { const float send = up ? v[i] : v[i + o], keep = up ? v[i + o] : v[i]; v[i] = keep + __shfl_xor(send, o); if ((i & 7) == 7) asm volatile("" ::: "memory"); } }
        const int e = lane & 31; float val = v[0] + rbias;
        int sel[4]; float sv[4];
#pragma unroll
        for (int r = 0; r < 4; ++r) { float mx = val;
#pragma unroll
            for (int o = 16; o >= 1; o >>= 1) mx = fmaxf(mx, __shfl_xor(mx, o));
            const unsigned long long bal = __builtin_amdgcn_ballot_w64(val == mx);
            const unsigned half = (unsigned)(lane < 32 ? bal : (bal >> 32));
            const int w = __builtin_ctz(half); sel[r] = w; sv[r] = mx; if (e == w) val = -INFINITY; }
        const float e1 = __expf(sv[1] - sv[0]), e2 = __expf(sv[2] - sv[0]), e3 = __expf(sv[3] - sv[0]); const float inv = 1.f / (1.f + e1 + e2 + e3);
        const float gv[4] = {inv, e1 * inv, e2 * inv, e3 * inv};
        if (e == 0) { const int m = m0 + (lane >> 5);
#pragma unroll
            for (int r = 0; r < 4; ++r) { const unsigned lr = __hip_atomic_fetch_add(lcnt + sel[r], 1u, __ATOMIC_RELAXED, __HIP_MEMORY_SCOPE_WORKGROUP);
                const unsigned slot = __hip_atomic_fetch_add(lnent, 1u, __ATOMIC_RELAXED, __HIP_MEMORY_SCOPE_WORKGROUP);
                lent[3 * slot] = ((unsigned)sel[r] << 24) | lr; lent[3 * slot + 1] = (unsigned)(m * 4 + r); lent[3 * slot + 2] = __float_as_uint(gv[r]); } }
    }
    __syncthreads();
    if (tid < 32) lbase[tid] = atomicAdd(cnt + tid * 64, lcnt[tid]);
    __syncthreads();
    { const unsigned nent = *lnent;
      for (unsigned i = tid; i < nent; i += NTHR) { const unsigned w = lent[3 * i]; const unsigned e = w >> 24; const size_t pos = (size_t)e * CAP + lbase[e] + (w & 0xFFFFFFu);
          list[pos] = (int)lent[3 * i + 1]; gl[pos] = __uint_as_float(lent[3 * i + 2]); } }
}

__device__ __forceinline__ void phase_combine(KPP p, int l) {
    const int lane = otid() & 63, wave = otid() >> 6, gw = obid() * NWAVES + wave, ngw = gridDim.x * NWAVES;
    const int mhi = l == 0 ? NTOK : NLAT;
    const float* MOD = WSP(float, WS_MOD) + (size_t)l * 5 * 6144; bf16_t* X = WSP(bf16_t, WS_X); const bf16_t* YK = WSP(bf16_t, WS_YK);
    u32x2 px[4]; u32x2 py[4][4];
#define CB_FETCH(m_) do { _Pragma("unroll") for (int j = 0; j < 4; ++j) { const int k = 4 * (lane + 64 * j); px[j] = *(const u32x2*)(X + (size_t)(m_) * D + k); \
        _Pragma("unroll") for (int r = 0; r < 4; ++r) py[j][r] = *(const u32x2*)(YK + (size_t)((m_) * 4 + r) * 1024 + k); } } while (0)
    if (gw < mhi) CB_FETCH(gw);
    f32x4 gfin[4];
#pragma unroll
    for (int j = 0; j < 4; ++j) gfin[j] = *(const f32x4*)((l == 0 ? p->in[I_N1G] + 1024 : p->in[I_FNG]) + 4 * (lane + 64 * j));
    const float* MOD1 = WSP(float, WS_MOD) + (size_t)5 * 6144;
    for (int m = gw; m < mhi; m += ngw) {
        const int mr = m < NLAT ? (m >> 13) : 4; const float* g2 = MOD + mr * 6144 + 5 * 1024;
        f32x4 g2v[4], sh[4], sc[4];
#pragma unroll
        for (int j = 0; j < 4; ++j) { const int k = 4 * (lane + 64 * j); g2v[j] = *(const f32x4*)(g2 + k);
            if (l == 0) { sh[j] = *(const f32x4*)(MOD1 + mr * 6144 + k); sc[j] = *(const f32x4*)(MOD1 + mr * 6144 + 1024 + k); } }
        f32x4 v[4];
#pragma unroll
        for (int j = 0; j < 4; ++j) { f32x4 s = (f32x4){0.f, 0.f, 0.f, 0.f};
#pragma unroll
            for (int r = 0; r < 4; ++r) s += (f32x4){bflo(py[j][r].x), bfhi(py[j][r].x), bflo(py[j][r].y), bfhi(py[j][r].y)};
            v[j] = (f32x4){bflo(px[j].x), bfhi(px[j].x), bflo(px[j].y), bfhi(px[j].y)} + g2v[j] * s; }
        asm volatile("" ::: "memory");
        if (m + ngw < mhi) CB_FETCH(m + ngw);
        if (l == 0) {
#pragma unroll
            for (int j = 0; j < 4; ++j) { u32x2 w; w.x = pk2(v[j][0], v[j][1]); w.y = pk2(v[j][2], v[j][3]); *(u32x2*)(X + (size_t)m * D + 4 * (lane + 64 * j)) = w; }
            norm_mod_store_r(v, gfin, sh, sc, WSP(bf16_t, WS_H) + (size_t)m * D, lane);
        } else {
            float ss = 0.f;
#pragma unroll
            for (int j = 0; j < 4; ++j) ss += (v[j][0] * v[j][0] + v[j][1] * v[j][1]) + (v[j][2] * v[j][2] + v[j][3] * v[j][3]);
            const float rstd = rsqrtf(wsum(ss) * (1.f / 1024.f) + 1e-6f);
#pragma unroll
            for (int j = 0; j < 4; ++j) { const int k = 4 * (lane + 64 * j); *(f32x4*)(p->out + (size_t)m * D + k) = v[j] * rstd * gfin[j]; }
        }
    }
#undef CB_FETCH
}

__device__ __forceinline__ void moe_prefix(KPP p, int l, LAS int* tp) {
    if (otid() == 0) { const unsigned* cnt = WSP(unsigned, WS_CTL) + CW_CNT + l * 2048; int s = 0;
        int ub = 0;
        for (int e = 0; e < 32; ++e) { tp[e] = s; tp[96 + e] = ub; const int c_ = (int)cnt[e * 64]; s += (c_ + 255) >> 8; ub += c_; } tp[32] = s; }
    __syncthreads();
}

constexpr int N_PHASES = 22;
template <int PH> __device__ __forceinline__ void run_phase(KPP p, int l, LAS unsigned char* lds) {
    if constexpr (PH == 0) phase_p0a(p, lds);
    if constexpr (PH == 1) phase_norm1(p, 0, p->in[I_X], p->in[I_CTX]);
    if constexpr (PH == 2) {
        pg8::DenseOrder S; S.init(NTOK, INP, gridDim.x, obid(), WSP(bf16_t, WS_WIN) + (size_t)l * INP * 1024);
        pg8::EpiInProj E{WSP(bf16_t, WS_U)};
        pg8::gemm_phase(lds, WSP(const unsigned char, WS_H), S, E); }
    if constexpr (PH == 3) { phase_prep(p, l, lds); __syncthreads(); mlstm_phaseA(p, l, lds); }
    if constexpr (PH == 12) {
        const int bid = obid(), G = gridDim.x, ncop = 8 * (G >> 6) + ((G & 63) < 8 ? (G & 63) : 8);
        unsigned* wctr = WSP(unsigned, WS_CTL) + CW_ATT + l * 64 + 16; unsigned* done = WSP(unsigned, WS_CTL) + CW_ATT + l * 64 + 32;
        if ((bid & 63) < 8 && G - ncop > 0) {
            const int tid = otid(), wave = tid >> 6, lane = tid & 63; LAS float* scr = (LAS float*)(lds + 16384) + wave * (64 * 33);
            const int nit = l == 0 ? WC_N1 : WC_N2;
            for (;;) { int b0 = nit;
                if (lane == 0) { if (__hip_atomic_load(done, __ATOMIC_RELAXED, __HIP_MEMORY_SCOPE_AGENT) == 0u) b0 = (int)atomicAdd(wctr, 8u); }
                b0 = __builtin_amdgcn_readfirstlane(b0); if (b0 >= nit) break;
                const int b1 = b0 + 8 < nit ? b0 + 8 : nit;
                for (int it = b0; it < b1; ++it) weight_copy_item(p, l + 1, it, scr, lane); }
        } else {
            const int rank = bid - 8 * (bid >> 6) - ((bid & 63) < 8 ? (bid & 63) : 8);
            rwkv_phaseA(p, l, lds, G - ncop > 0 ? rank : bid, G - ncop > 0 ? G - ncop : G);
            __syncthreads();
            if (otid() == 0) atomicAdd(done, 1u);
        } }
    if constexpr (PH == 11) mixer_phaseC(p, l, lds);
    if constexpr (PH == 4) phase_scan_attn(p, l, lds);
    if constexpr (PH == 6) {
        pg8::DenseOrder S; S.init(l == 0 ? NTOK : NLAT, D, gridDim.x, obid(), WSP(bf16_t, WS_WOUT) + (size_t)l * 1024 * 1024);
        pg8::EpiOutProj E{p->in[I_X], p->in[I_CTX], WSP(bf16_t, WS_X), WSP(const float, WS_MOD) + (size_t)l * 5 * 6144, l};
        pg8::gemm_phase(lds, WSP(const unsigned char, WS_MIX), S, E); }
    if constexpr (PH == 7) phase_router(p, l, lds);
    if constexpr (PH == 8) {
        LAS int* tp = (LAS int*)(lds + MISC_OFF); moe_prefix(p, l, tp);
        pg8::MoeOrder S{tp, WSP(const int, WS_LIST), WSP(const int, WS_CTL) + CW_CNT + l * 2048, 8, (int)gridDim.x, (int)obid(), 2,
                        WSP(const unsigned char, WS_W1) + (size_t)l * 32 * 2048 * 1024 * 2, (size_t)2048 * 1024 * 2};
        pg8::EpiMoe1 E{tp, p->in[I_B1] + (size_t)l * 32 * 2048, WSP(bf16_t, WS_HB)};
        pg8::gemm_phase(lds, WSP(const unsigned char, WS_H), S, E); }
    if constexpr (PH == 9) {
        LAS int* tp = (LAS int*)(lds + MISC_OFF); moe_prefix(p, l, tp);
        pg8::MoeOrder S{tp, WSP(const int, WS_LIST), WSP(const int, WS_CTL) + CW_CNT + l * 2048, 4, (int)gridDim.x, (int)obid(), 0,
                        WSP(const unsigned char, WS_W2) + (size_t)l * 32 * 1024 * 1024 * 2, (size_t)1024 * 1024 * 2};
        pg8::EpiMoe2 E{WSP(const int, WS_LIST), p->in[I_B2] + (size_t)l * 32 * 1024, WSP(const float, WS_GL), WSP(bf16_t, WS_YK)};
        pg8::gemm_phase(lds, WSP(const unsigned char, WS_HB), S, E); }
    if constexpr (PH == 10) phase_combine(p, l);
}
__global__ void __launch_bounds__(NTHR, 2) mk_fwd(KP p_unused) {
    extern __shared__ __attribute__((aligned(16))) unsigned char lds_raw[];
    LAS unsigned char* lds = (LAS unsigned char*)lds_raw;
    cg::grid_group grid = cg::this_grid();
    { KPP p = kp_ptr(); if (otid() < 2) ((volatile LAS unsigned*)(lds + BAR_ST_OFF))[otid()] = 0u; __syncthreads(); xcd_barrier_post(WSP(unsigned, WS_CTL) + CW_BAR); }
    int ph = 0;
#define PHASE(PH, l) do { KPP p = kp_ptr(); if (ph >= p->ph_lo && ph < p->ph_hi) { run_phase<PH>(p, l, lds); if (ph + 1 < p->ph_hi) { if (p->ph_hi > 1000) grid.sync(); else xcd_barrier(WSP(unsigned, WS_CTL) + CW_BAR, lds); } } ++ph; } while (0)
    PHASE(0, 0); PHASE(1, 0);
    for (int l = 0; l < 2; ++l) { PHASE(2, l); PHASE(3, l); PHASE(12, l); PHASE(4, l); PHASE(11, l); PHASE(6, l); PHASE(7, l); PHASE(8, l); PHASE(9, l); PHASE(10, l); }
#undef PHASE
}

#ifndef MK_PER_PHASE
#define MK_PER_PHASE 0
#endif
extern "C" void kernel_launch(void* const* d_in, const int* in_sizes, int n_in, void* d_out, int out_size, void* d_ws, size_t ws_size, hipStream_t stream) {
    static int grid = 0;
    if (grid == 0) {
        if (n_in != 35 || out_size != NLAT * D || ws_size < WS_END) { fprintf(stderr, "kernel_launch: unexpected sizes n_in %d out %d ws %zu (need %zu)\n", n_in, out_size, ws_size, (size_t)WS_END); grid = -1; return; }
        int dev = 0, cus = 0, per_cu = 0;
        (void)hipGetDevice(&dev); (void)hipDeviceGetAttribute(&cus, hipDeviceAttributeMultiprocessorCount, dev);
        (void)hipFuncSetAttribute((const void*)mk_fwd, hipFuncAttributeMaxDynamicSharedMemorySize, LDS_BYTES);
        (void)hipOccupancyMaxActiveBlocksPerMultiprocessor(&per_cu, (const void*)mk_fwd, NTHR, LDS_BYTES);
        if (per_cu < 1) { fprintf(stderr, "kernel_launch: occupancy query says %d blocks per CU\n", per_cu); grid = -1; return; }
        grid = cus > 0 ? cus : 256;
        (void)hipGetLastError();
    }
    if (grid < 0) return;
    (void)hipMemsetAsync((char*)d_ws + WS_CTL, 0, CTL_ZERO_BYTES, stream);
    KP p{};
    for (int i = 0; i < 35; ++i) p.in[i] = (const float*)d_in[i];
    p.out = (float*)d_out; p.ws = (unsigned char*)d_ws;
#if MK_PER_PHASE
    for (int ph = 0; ph < N_PHASES; ++ph) { p.ph_lo = ph; p.ph_hi = ph + 1; void* args[] = {&p};
        hipError_t e = hipLaunchCooperativeKernel((const void*)mk_fwd, dim3(grid), dim3(NTHR), args, LDS_BYTES, stream);
        if (e != hipSuccess) { fprintf(stderr, "launch %d failed: %s\n", ph, hipGetErrorString(e)); break; } }
#else
    p.ph_lo = 0; p.ph_hi = N_PHASES; void* args[] = {&p};
    hipError_t e = hipLaunchCooperativeKernel((const void*)mk_fwd, dim3(grid), dim3(NTHR), args, LDS_BYTES, stream);
    if (e != hipSuccess) fprintf(stderr, "cooperative launch failed: %s (grid %d)\n", hipGetErrorString(e), grid);
#endif
}
```
